# Optimizing an MI355X kernel written in HIP

```python
import jax, jax.numpy as jnp
from jax import lax
import numpy as np

D_MODEL = 2048
BATCH = 1
SEQ = 8192
DEPTH = 4

N_MIXERS = 2
N_A_LAYERS = (DEPTH + 1) // 2
N_B_LAYERS = DEPTH // 2
EPS = 1e-6

EXPAND = 2
CHUNK = 128
A_WIDTH = EXPAND * D_MODEL
A_GROUPS = 16
A_GROUP_DIM = A_WIDTH // A_GROUPS

B_HEAD_DIM = 128
B_HEADS = D_MODEL // B_HEAD_DIM
B_WIDTH = B_HEADS * B_HEAD_DIM
Q_BLOCK = 128
FORGET_BIAS_MEAN = 3.0

kernel_name = "hybrid_gmlp_fox_interleaved"


def rms_norm(x, g):
    xf = x.astype(jnp.float32)
    y = xf * lax.rsqrt(jnp.mean(xf * xf, axis=-1, keepdims=True) + EPS)
    return (y * g.astype(jnp.float32)).astype(x.dtype)


def spatial_gating_layer(x, norm_g, w_in, v_norm_g, w_s, b_s, w_out):
    b, s, _ = x.shape
    h = rms_norm(x, norm_g)
    u, v, z = jnp.split(h @ w_in, 3, axis=-1)
    u = jax.nn.gelu(u)
    v = rms_norm(jax.nn.gelu(v), v_norm_g)
    n_chunks = s // CHUNK
    v = v.reshape(b, n_chunks, CHUNK, A_GROUPS, A_GROUP_DIM)
    causal = jnp.tril(jnp.ones((CHUNK, CHUNK), dtype=bool))
    w_causal = jnp.where(causal[None], w_s, 0)
    mixed = jnp.einsum('gts,bcsgd->bctgd', w_causal, v) + b_s.T[None, None, :, :, None]
    mixed = mixed.reshape(b, s, A_WIDTH)
    y = u * mixed * jax.nn.silu(z)
    return y @ w_out


def forgetting_attention_layer(x, norm_g, w_in, f_bias, q_norm_g, k_norm_g, w_out):
    b, s, _ = x.shape
    h = rms_norm(x, norm_g)
    proj = h @ w_in
    q, k, v, z, f_logit = jnp.split(
        proj, [B_WIDTH, 2 * B_WIDTH, 3 * B_WIDTH, 4 * B_WIDTH], axis=-1)
    q = rms_norm(q.reshape(b, s, B_HEADS, B_HEAD_DIM), q_norm_g)
    k = rms_norm(k.reshape(b, s, B_HEADS, B_HEAD_DIM), k_norm_g)
    v = v.reshape(b, s, B_HEADS, B_HEAD_DIM)
    log_f = jax.nn.log_sigmoid((f_logit + f_bias).astype(jnp.float32))
    cum = jnp.cumsum(log_f, axis=1).transpose(0, 2, 1)
    scale = B_HEAD_DIM ** -0.5
    q_t = q.transpose(0, 2, 1, 3)
    k_t = k.transpose(0, 2, 1, 3)
    v_t = v.transpose(0, 2, 1, 3)
    n_blocks = s // Q_BLOCK
    q_blocks = q_t.reshape(b, B_HEADS, n_blocks, Q_BLOCK, B_HEAD_DIM).transpose(2, 0, 1, 3, 4)
    c_blocks = cum.reshape(b, B_HEADS, n_blocks, Q_BLOCK).transpose(2, 0, 1, 3)
    blk_idx = jnp.arange(n_blocks, dtype=jnp.int32)
    k_pos = jnp.arange(s, dtype=jnp.int32)

    def attend_block(args):
        q_blk, c_blk, i = args
        logits = jnp.einsum('bhqd,bhkd->bhqk', q_blk, k_t,
                            preferred_element_type=jnp.float32) * scale
        logits = logits + c_blk[..., :, None] - cum[:, :, None, :]
        q_pos = i * Q_BLOCK + jnp.arange(Q_BLOCK, dtype=jnp.int32)
        mask = k_pos[None, :] <= q_pos[:, None]
        logits = jnp.where(mask, logits, -jnp.inf)
        p = jax.nn.softmax(logits, axis=-1).astype(v_t.dtype)
        return jnp.einsum('bhqk,bhkd->bhqd', p, v_t)

    out = lax.map(attend_block, (q_blocks, c_blocks, blk_idx))
    out = out.transpose(1, 0, 3, 2, 4).reshape(b, s, B_WIDTH)
    y = out * jax.nn.silu(z)
    return y @ w_out


def setup_inputs(seed: int = 0) -> dict:
    key = jax.random.key(seed)
    ks = jax.random.split(key, 13)
    f32 = jnp.float32
    x = jax.random.normal(ks[0], (BATCH, SEQ, D_MODEL), f32)
    a_norm_g = 1.0 + 0.05 * jax.random.normal(ks[1], (N_A_LAYERS, D_MODEL), f32)
    a_w_in = jax.random.normal(ks[2], (N_A_LAYERS, D_MODEL, 3 * A_WIDTH), f32) * D_MODEL ** -0.5
    a_v_norm_g = 1.0 + 0.05 * jax.random.normal(ks[3], (N_A_LAYERS, A_WIDTH), f32)
    a_w_s = jax.random.normal(ks[4], (N_A_LAYERS, A_GROUPS, CHUNK, CHUNK), f32) * CHUNK ** -0.5
    a_b_s = 1.0 + 0.1 * jax.random.normal(ks[5], (N_A_LAYERS, A_GROUPS, CHUNK), f32)
    a_w_out = jax.random.normal(ks[6], (N_A_LAYERS, A_WIDTH, D_MODEL), f32) * A_WIDTH ** -0.5
    b_norm_g = 1.0 + 0.05 * jax.random.normal(ks[7], (N_B_LAYERS, D_MODEL), f32)
    b_w_in = jax.random.normal(ks[8], (N_B_LAYERS, D_MODEL, 4 * B_WIDTH + B_HEADS), f32) * D_MODEL ** -0.5
    b_f_bias = FORGET_BIAS_MEAN + 0.5 * jax.random.normal(ks[9], (N_B_LAYERS, B_HEADS), f32)
    b_q_norm_g = 1.0 + 0.05 * jax.random.normal(ks[10], (N_B_LAYERS, B_HEAD_DIM), f32)
    b_k_norm_g = 1.0 + 0.05 * jax.random.normal(ks[11], (N_B_LAYERS, B_HEAD_DIM), f32)
    b_w_out = jax.random.normal(ks[12], (N_B_LAYERS, B_WIDTH, D_MODEL), f32) * B_WIDTH ** -0.5
    return {"x": x, "a_norm_g": a_norm_g, "a_w_in": a_w_in, "a_v_norm_g": a_v_norm_g,
            "a_w_s": a_w_s, "a_b_s": a_b_s, "a_w_out": a_w_out,
            "b_norm_g": b_norm_g, "b_w_in": b_w_in, "b_f_bias": b_f_bias,
            "b_q_norm_g": b_q_norm_g, "b_k_norm_g": b_k_norm_g, "b_w_out": b_w_out}


def reference(x, a_norm_g, a_w_in, a_v_norm_g, a_w_s, a_b_s, a_w_out,
              b_norm_g, b_w_in, b_f_bias, b_q_norm_g, b_k_norm_g, b_w_out):
    for i in range(DEPTH):
        j = i // N_MIXERS
        if i % N_MIXERS == 0:
            x = x + spatial_gating_layer(x, a_norm_g[j], a_w_in[j], a_v_norm_g[j],
                                         a_w_s[j], a_b_s[j], a_w_out[j])
        else:
            x = x + forgetting_attention_layer(x, b_norm_g[j], b_w_in[j], b_f_bias[j],
                                               b_q_norm_g[j], b_k_norm_g[j], b_w_out[j])
    return x
```

```cpp
#include <hip/hip_runtime.h>
#include <hip/hip_cooperative_groups.h>
#include <cstdio>
#include <cstdint>
namespace cg = cooperative_groups;

#ifndef MK_MULTI
#define MK_MULTI 0
#endif

#define LAS __attribute__((address_space(3)))
typedef unsigned short bf16_t;
typedef short bf16x8 __attribute__((ext_vector_type(8)));
typedef short s16x4 __attribute__((ext_vector_type(4)));
typedef float f32x2 __attribute__((ext_vector_type(2)));
typedef float f32x4 __attribute__((ext_vector_type(4)));
typedef float f32x16 __attribute__((ext_vector_type(16)));
typedef unsigned u32x2 __attribute__((ext_vector_type(2)));
typedef unsigned u32x4 __attribute__((ext_vector_type(4)));

constexpr int S = 8192, DM = 2048, AW = 4096, NAIN = 3 * AW, NBIN = 4 * DM, NBIN_LD = 4 * DM + 16, NH = 16, HD = 128, CH = 128, NG = 16, GD = 256;
constexpr int PADK = 64;
constexpr int LDX = DM + PADK, LDA4 = AW + PADK;
constexpr float EPS = 1e-6f;
constexpr float LOG2E = 1.4426950408889634f;
constexpr float QSCALE = 0.08838834764831845f * 1.4426950408889634f;

constexpr size_t SZ_WAIN = (size_t)NAIN * LDX * 2, SZ_WAOUT = (size_t)DM * LDA4 * 2, SZ_WBIN = (size_t)NBIN * LDX * 2, SZ_WBF = (size_t)32 * DM * 2, SZ_WBOUT = (size_t)DM * LDX * 2;
constexpr size_t WS_WAIN = 0;
constexpr size_t WS_WAOUT = WS_WAIN + 2 * SZ_WAIN;
constexpr size_t WS_WBIN = WS_WAOUT + 2 * SZ_WAOUT;
constexpr size_t WS_WBF = WS_WBIN + 2 * SZ_WBIN;
constexpr size_t WS_WBOUT = WS_WBF + 2 * SZ_WBF;
constexpr size_t WS_XB = WS_WBOUT + 2 * SZ_WBOUT;
constexpr size_t WS_U = WS_XB + (size_t)S * LDX * 2;
constexpr size_t WS_V = WS_U + (size_t)S * LDA4 * 2;
constexpr size_t WS_Z = WS_V + (size_t)S * LDA4 * 2;
constexpr size_t WS_Y = WS_Z + (size_t)S * LDA4 * 2;
constexpr size_t WS_ROWSQ = WS_Y + (size_t)S * LDA4 * 2;
constexpr size_t WS_VSQ = WS_ROWSQ + (size_t)4 * S * 8 * 4;
constexpr size_t WS_FLOG = WS_VSQ + (size_t)2 * S * 16 * 4;
constexpr size_t WS_WSB = WS_FLOG + (size_t)NH * S * 4;
constexpr size_t WS_BAR = WS_WSB + (size_t)2 * NG * CH * CH * 2;
constexpr size_t WS_END = WS_BAR + 256;

struct Params {
    const float* x; const float* a_norm_g; const float* a_w_in; const float* a_v_norm_g; const float* a_w_s; const float* a_b_s; const float* a_w_out;
    const float* b_norm_g; const float* b_w_in; const float* b_f_bias; const float* b_q_norm_g; const float* b_k_norm_g; const float* b_w_out;
    float* out; unsigned char* ws; int ph_lo, ph_hi;
};

__device__ __forceinline__ unsigned cvtpk(float lo, float hi) { unsigned r; asm volatile("v_cvt_pk_bf16_f32 %0, %1, %2" : "=v"(r) : "v"(lo), "v"(hi)); return r; }
__device__ __forceinline__ float bf2f(unsigned short b) { return __uint_as_float(((unsigned)b) << 16); }
__device__ __forceinline__ float wave_sum(float v) {
#pragma unroll
    for (int o = 32; o; o >>= 1) v += __shfl_xor(v, o);
    return v;
}
__device__ __forceinline__ float gelu_tanh(float x) {
    const float t = x * (1.f + 0.044715f * x * x);
    const float e = __builtin_amdgcn_exp2f(-2.3022082f * t);
    return x * __builtin_amdgcn_rcpf(1.f + e);
}
__device__ __forceinline__ float gate_uz(float u, float z) {
    const float t = u * (1.f + 0.044715f * u * u);
    const float eu = __builtin_amdgcn_exp2f(-2.3022082f * t), ez = __builtin_amdgcn_exp2f(-LOG2E * z);
    return (u * z) * __builtin_amdgcn_rcpf((1.f + eu) * (1.f + ez));
}
__device__ __forceinline__ float silu(float x) { return x * __builtin_amdgcn_rcpf(1.f + __builtin_amdgcn_exp2f(-LOG2E * x)); }
__device__ __forceinline__ bf16x8 pack8(f32x4 a, f32x4 b) {
    u32x4 w = {cvtpk(a[0], a[1]), cvtpk(a[2], a[3]), cvtpk(b[0], b[1]), cvtpk(b[2], b[3])};
    return *reinterpret_cast<bf16x8*>(&w);
}

namespace pg8 {
constexpr int BM = 256, BK = 64, HALF = 128, HTB = HALF * BK * 2, STAGE_BYTES = 8 * HTB, NXCD = 8, WGM = 8;
__host__ __device__ __forceinline__ int lds_byte(int r, int c) { const int st = (r >> 4) * 2 + (c >> 5), rr = r & 15, cc = c & 31, ob = rr * 64 + cc * 2; return st * 1024 + (ob ^ (((ob >> 9) & 1) << 5)); }
__host__ __device__ __forceinline__ void stage_rc(int b, int& R, int& C) { const int st = b / 1024, sb = b % 1024, swz = sb ^ (((sb >> 9) & 1) << 5); R = (st >> 1) * 16 + swz / 64; C = (st & 1) * 32 + (swz % 64) / 2; }
__host__ __device__ __forceinline__ int perm32(int rho) { const int n = rho >> 4, i = rho & 15; return 8 * (i >> 2) + 4 * n + (i & 3); }
struct Unit { int pm, pn; };
struct Gemm { const bf16_t* A; const bf16_t* Bt; int M, N, K, lda, ldb; };
struct StaticOrder {
    int nM, nN, nwg, G, c;
    __device__ void init(int M, int N, int G_, int c_) { nM = M / BM; nN = N / BM; nwg = nM * nN; G = G_; c = c_; }
    __device__ bool next(int i, Unit& u) const {
        const long L = (long)i * G + c; if (L >= nwg) return false;
        int wgid = (int)L; { const int q = nwg / NXCD, r = nwg % NXCD, xcd = wgid % NXCD, off = wgid / NXCD; wgid = (xcd < r ? xcd * (q + 1) : r * (q + 1) + (xcd - r) * q) + off; }
        const int nig = WGM * nN, gid = wgid / nig, fm = gid * WGM, gsz = (nM - fm) < WGM ? (nM - fm) : WGM;
        u.pm = fm + ((wgid % nig) % gsz); u.pn = (wgid % nig) / gsz; return true;
    }
};
#ifndef PG8_SP2
#define PG8_SP2 true
#endif
#ifndef PG8_ALIGN
#define PG8_ALIGN true
#endif
template <class Epi, bool ALIGN_EPI = PG8_ALIGN, bool SP2 = PG8_SP2>
__device__ __forceinline__ void gemm_phase(LAS unsigned char* lds, const Gemm g, const StaticOrder& S_, const Epi& E, const int tid) {
    const int wid = __builtin_amdgcn_readfirstlane(tid >> 6), lane = tid & 63, wr = wid >> 2, wc = wid & 3, fr = lane & 15, fq = lane >> 4;
    const int K = g.K, nt = K / BK;
    unsigned voffA[2], voffB[2];
#pragma unroll
    for (int i = 0; i < 2; ++i) { int R, C; stage_rc(tid * 16 + i * 8192, R, C); const int Rb = Epi::PERM ? ((R & ~31) + perm32(R & 31)) : R;
        voffA[i] = (unsigned)(R * g.lda + C) * 2u; voffB[i] = (unsigned)(Rb * g.ldb + C) * 2u; }
    const size_t kstep = (size_t)(BK * 2);
    const size_t hstepA = (size_t)HALF * g.lda * 2, hstepB = (size_t)HALF * g.ldb * 2;
    const size_t tstepA = 2 * hstepA, tstepB = 2 * hstepB;
    const unsigned ldsw = (unsigned)wid * 1024u;
    const int aoff = lds_byte(wr * 64 + fr, fq * 8), boff = lds_byte(wc * 32 + fr, fq * 8);
#define PG8_SA(b, h) (((b) * 2 + (h)) * HTB)
#define PG8_SB(b, h) ((4 + (b) * 2 + (h)) * HTB)
#define PG8_STAGE(bufoff, gbase, voff) do { _Pragma("unroll") for (int _i = 0; _i < 2; ++_i) \
        __builtin_amdgcn_global_load_lds((const unsigned*)((const char*)(gbase) + (voff)[_i]), (LAS unsigned*)(lds + (bufoff) + ldsw + _i * 8192), 16, 0, 0); } while (0)
#define PG8_LDA(dst, b, h) do { _Pragma("unroll") for (int m = 0; m < 4; ++m) _Pragma("unroll") for (int k = 0; k < 2; ++k) dst[m][k] = *(const LAS bf16x8*)(lds + PG8_SA(b, h) + aoff + m * 2048 + k * 1024); } while (0)
#define PG8_LDB(dst, b, h) do { _Pragma("unroll") for (int n = 0; n < 2; ++n) _Pragma("unroll") for (int k = 0; k < 2; ++k) dst[n][k] = *(const LAS bf16x8*)(lds + PG8_SB(b, h) + boff + n * 2048 + k * 1024); } while (0)
#define PG8_MMA(ai, bj, At, Bt) do { __builtin_amdgcn_s_setprio(1); _Pragma("unroll") for (int m = 0; m < 4; ++m) _Pragma("unroll") for (int n = 0; n < 2; ++n) _Pragma("unroll") for (int k = 0; k < 2; ++k) \
        acc[ai][bj][m][n] = __builtin_amdgcn_mfma_f32_16x16x32_bf16(Bt[n][k], At[m][k], acc[ai][bj][m][n], 0, 0, 0); __builtin_amdgcn_s_setprio(0); } while (0)
#define PG8_WAIT_V(n) asm volatile("s_waitcnt vmcnt(" #n ")" ::: "memory")
#define PG8_WAIT_L(n) asm volatile("s_waitcnt lgkmcnt(" #n ")" ::: "memory")
#define PG8_BAR __builtin_amdgcn_s_barrier()
#define PG8_SCHED __builtin_amdgcn_sched_barrier(0)
    Unit cur, nxt; int ui = 0;
    if (!S_.next(0, cur)) return;
    f32x4 acc[2][2][4][2];
#pragma unroll
    for (int a = 0; a < 2; ++a)
#pragma unroll
        for (int b = 0; b < 2; ++b)
#pragma unroll
            for (int m = 0; m < 4; ++m)
#pragma unroll
                for (int n = 0; n < 2; ++n) acc[a][b][m][n] = (f32x4){0.f, 0.f, 0.f, 0.f};
    bf16x8 At[4][2], B0[2][2], B1[2][2];
    const char* cA = (const char*)g.A + (size_t)cur.pm * tstepA; const char* cB = (const char*)g.Bt + (size_t)cur.pn * tstepB;
    if constexpr (SP2) {
        PG8_STAGE(PG8_SB(0, 0), cB, voffB); PG8_STAGE(PG8_SB(0, 1), cB + hstepB, voffB); PG8_STAGE(PG8_SA(0, 0), cA, voffA); PG8_STAGE(PG8_SA(0, 1), cA + hstepA, voffA);
        if (wr == 1) PG8_BAR;
        PG8_WAIT_V(2); PG8_BAR;
        PG8_STAGE(PG8_SB(1, 0), cB + kstep, voffB); PG8_STAGE(PG8_SA(1, 0), cA + kstep, voffA); PG8_STAGE(PG8_SB(1, 1), cB + hstepB + kstep, voffB);
        PG8_WAIT_V(6); PG8_BAR;
    } else {
        PG8_STAGE(PG8_SB(0, 0), cB, voffB); PG8_STAGE(PG8_SA(0, 0), cA, voffA); PG8_STAGE(PG8_SB(0, 1), cB + hstepB, voffB); PG8_STAGE(PG8_SA(0, 1), cA + hstepA, voffA);
        if (wr == 1) PG8_BAR;
        PG8_WAIT_V(4); PG8_BAR;
        PG8_STAGE(PG8_SB(1, 0), cB + kstep, voffB); PG8_STAGE(PG8_SA(1, 0), cA + kstep, voffA); PG8_STAGE(PG8_SB(1, 1), cB + hstepB + kstep, voffB);
        PG8_WAIT_V(6); PG8_BAR;
    }
    for (;;) {
        const bool has_next = S_.next(ui + 1, nxt);
        const char* nA = has_next ? (const char*)g.A + (size_t)nxt.pm * tstepA : cA; const char* nB = has_next ? (const char*)g.Bt + (size_t)nxt.pn * tstepB : cB;
        for (int t = 0; t < nt; t += 2) {
            const bool last = (t == nt - 2);
            const char* a1 = cA + (size_t)(t + 1) * kstep;
            const char* a2 = last ? nA : cA + (size_t)(t + 2) * kstep; const char* b2 = last ? nB : cB + (size_t)(t + 2) * kstep;
            const char* a3 = a2 + kstep; const char* b3 = b2 + kstep;
            if constexpr (SP2) {
            PG8_LDB(B0, 0, 0); PG8_LDB(B1, 0, 1); PG8_SCHED; PG8_LDA(At, 0, 0); PG8_STAGE(PG8_SA(1, 1), a1 + hstepA, voffA);
            PG8_WAIT_V(8); PG8_WAIT_L(0); PG8_BAR; PG8_MMA(0, 0, At, B0); PG8_MMA(0, 1, At, B1); PG8_BAR; PG8_SCHED;
            PG8_LDA(At, 0, 1); PG8_STAGE(PG8_SB(0, 0), b2, voffB); PG8_STAGE(PG8_SB(0, 1), b2 + hstepB, voffB); PG8_STAGE(PG8_SA(0, 0), a2, voffA);
            PG8_WAIT_V(8); PG8_WAIT_L(0); PG8_BAR; PG8_MMA(1, 0, At, B0); PG8_MMA(1, 1, At, B1); PG8_BAR; PG8_SCHED;
            PG8_LDB(B0, 1, 0); PG8_LDB(B1, 1, 1); PG8_SCHED; PG8_LDA(At, 1, 0); PG8_STAGE(PG8_SA(0, 1), a2 + hstepA, voffA);
            PG8_WAIT_V(8); PG8_WAIT_L(0); PG8_BAR; PG8_MMA(0, 0, At, B0); PG8_MMA(0, 1, At, B1); PG8_BAR; PG8_SCHED;
            PG8_LDA(At, 1, 1); PG8_STAGE(PG8_SB(1, 0), b3, voffB); PG8_STAGE(PG8_SB(1, 1), b3 + hstepB, voffB); PG8_STAGE(PG8_SA(1, 0), a3, voffA);
            PG8_WAIT_V(8); PG8_WAIT_L(0); PG8_BAR; PG8_MMA(1, 0, At, B0); PG8_MMA(1, 1, At, B1); PG8_BAR; PG8_SCHED;
            } else {
            PG8_LDB(B0, 0, 0); PG8_SCHED; PG8_LDA(At, 0, 0); PG8_STAGE(PG8_SA(1, 1), a1 + hstepA, voffA);
            PG8_WAIT_L(8); PG8_BAR; PG8_WAIT_L(0); PG8_MMA(0, 0, At, B0); PG8_BAR; PG8_SCHED;
            PG8_LDB(B1, 0, 1); PG8_STAGE(PG8_SB(0, 0), b2, voffB);
            PG8_BAR; PG8_WAIT_L(0); PG8_MMA(0, 1, At, B1); PG8_BAR;
            PG8_LDA(At, 0, 1); PG8_STAGE(PG8_SA(0, 0), a2, voffA);
            PG8_BAR; PG8_WAIT_L(0); PG8_MMA(1, 0, At, B0); PG8_BAR; PG8_SCHED;
            PG8_STAGE(PG8_SB(0, 1), b2 + hstepB, voffB);
            PG8_WAIT_V(6); PG8_BAR; PG8_MMA(1, 1, At, B1); PG8_BAR;
            PG8_LDB(B0, 1, 0); PG8_SCHED; PG8_LDA(At, 1, 0); PG8_STAGE(PG8_SA(0, 1), a2 + hstepA, voffA);
            PG8_WAIT_L(8); PG8_BAR; PG8_WAIT_L(0); PG8_MMA(0, 0, At, B0); PG8_BAR; PG8_SCHED;
            PG8_LDB(B1, 1, 1); PG8_STAGE(PG8_SB(1, 0), b3, voffB);
            PG8_BAR; PG8_WAIT_L(0); PG8_MMA(0, 1, At, B1); PG8_BAR;
            PG8_LDA(At, 1, 1); PG8_STAGE(PG8_SA(1, 0), a3, voffA);
            PG8_BAR; PG8_WAIT_L(0); PG8_MMA(1, 0, At, B0); PG8_BAR; PG8_SCHED;
            PG8_STAGE(PG8_SB(1, 1), b3 + hstepB, voffB);
            PG8_WAIT_V(6); PG8_BAR; PG8_MMA(1, 1, At, B1); PG8_BAR;
            }
        }
        if constexpr (ALIGN_EPI) { if (wr == 0) PG8_BAR; }
        if constexpr (!Epi::AFTER_DRAIN) E(acc, cur, wr, wc, fr, fq);
        if (!has_next) break;
#pragma unroll
        for (int a = 0; a < 2; ++a)
#pragma unroll
            for (int b = 0; b < 2; ++b)
#pragma unroll
                for (int m = 0; m < 4; ++m)
#pragma unroll
                    for (int n = 0; n < 2; ++n) acc[a][b][m][n] = (f32x4){0.f, 0.f, 0.f, 0.f};
        cur = nxt; cA = nA; cB = nB; ++ui;
        if constexpr (ALIGN_EPI) { if (wr == 1) PG8_BAR; }
    }
    PG8_WAIT_V(0);
    if constexpr (!ALIGN_EPI) { if (wr == 0) PG8_BAR; }
    PG8_BAR;
    if constexpr (Epi::AFTER_DRAIN) E.fused(acc, cur, wr, wc, fr, fq, lds, wid, lane);
#undef PG8_SA
#undef PG8_SB
#undef PG8_STAGE
#undef PG8_LDA
#undef PG8_LDB
#undef PG8_MMA
#undef PG8_WAIT_V
#undef PG8_WAIT_L
#undef PG8_BAR
#undef PG8_SCHED
}
}
using pg8::Unit;
typedef f32x4 AccT[2][2][4][2];

__device__ __forceinline__ float row_rstd8(const float* part) {
    const f32x4 a = *(const f32x4*)part, b = *(const f32x4*)(part + 4);
    return __builtin_amdgcn_rsqf((((a[0] + a[1]) + (a[2] + a[3])) + ((b[0] + b[1]) + (b[2] + b[3]))) * (1.f / DM) + EPS);
}
struct EpiAIn {
    static constexpr bool PERM = true, AFTER_DRAIN = false;
    bf16_t* G; bf16_t* V; const float* rowsq; float* vsq; int dry; LAS float* xbuf;
    __device__ __forceinline__ void operator()(const AccT& acc, const Unit& u, int wr, int wc, int fr, int fq) const {
        const bool isv = u.pn >= 32;
        int c8 = wc * 32 + 8 * fq; asm volatile("" : "+v"(c8));
        const int row0 = u.pm * 256 + wr * 64 + fr;
        float rstd[2][4];
#pragma unroll
        for (int ai = 0; ai < 2; ++ai)
#pragma unroll
            for (int m = 0; m < 4; ++m) rstd[ai][m] = row_rstd8(rowsq + (size_t)(row0 + ai * 128 + m * 16) * 8);
        if (!isv) {
            const int col0 = u.pn * 128 + c8;
#pragma unroll
            for (int ai = 0; ai < 2; ++ai)
#pragma unroll
                for (int m = 0; m < 4; ++m) {
                    const int row = row0 + ai * 128 + m * 16;
                    f32x4 u0 = acc[ai][0][m][0] * rstd[ai][m], u1 = acc[ai][0][m][1] * rstd[ai][m], z0 = acc[ai][1][m][0] * rstd[ai][m], z1 = acc[ai][1][m][1] * rstd[ai][m];
#pragma unroll
                    for (int e = 0; e < 4; ++e) { u0[e] = gate_uz(u0[e], z0[e]); u1[e] = gate_uz(u1[e], z1[e]); }
                    *(bf16x8*)(G + (size_t)row * LDA4 + col0) = pack8(u0, u1);
                }
        } else {
            const int col0 = (u.pn - 32) * 256 + c8;
#pragma unroll
            for (int ai = 0; ai < 2; ++ai)
#pragma unroll
                for (int m = 0; m < 4; ++m) {
                    const int row = row0 + ai * 128 + m * 16;
                    float ss = 0.f;
#pragma unroll
                    for (int bj = 0; bj < 2; ++bj) {
                        f32x4 v0 = acc[ai][bj][m][0] * rstd[ai][m], v1 = acc[ai][bj][m][1] * rstd[ai][m];
#pragma unroll
                        for (int e = 0; e < 4; ++e) { v0[e] = gelu_tanh(v0[e]); v1[e] = gelu_tanh(v1[e]); ss += v0[e] * v0[e] + v1[e] * v1[e]; }
                        *(bf16x8*)(V + (size_t)row * LDA4 + col0 + bj * 128) = pack8(v0, v1);
                    }
                    ss += __shfl_xor(ss, 16); ss += __shfl_xor(ss, 32); if (fq == 0) xbuf[(ai * 128 + wr * 64 + m * 16 + fr) * 4 + wc] = ss;
                }
            asm volatile("s_waitcnt lgkmcnt(0)" ::: "memory"); __builtin_amdgcn_s_barrier(); asm volatile("" ::: "memory");
            if (wc == 0 && fq == 0 && !dry) {
#pragma unroll
                for (int ai = 0; ai < 2; ++ai)
#pragma unroll
                    for (int m = 0; m < 4; ++m) { const int rl = ai * 128 + wr * 64 + m * 16 + fr; const f32x4 q = *(const LAS f32x4*)(xbuf + rl * 4);
                        vsq[(size_t)(u.pm * 256 + rl) * 16 + (u.pn - 32)] = (q[0] + q[1]) + (q[2] + q[3]); }
            }
        }
    }
};
struct EpiOutDrain {
    static constexpr bool PERM = false, AFTER_DRAIN = true;
    const float* resid; const bf16_t* xb_in; float* out; bf16_t* xb; float* rowsq_next; int last; int dry;
    __device__ __forceinline__ void fused(const AccT& acc, const Unit& u, int wr, int wc, int fr, int fq, LAS unsigned char* lds, int wid, int lane) const {
        constexpr int SLD = 260;
        LAS float* slab = (LAS float*)lds;
        int c4 = 4 * lane; asm volatile("" : "+v"(c4));
#pragma unroll
        for (int ai = 0; ai < 2; ++ai) {
#pragma unroll
            for (int m = 0; m < 4; ++m)
#pragma unroll
                for (int bj = 0; bj < 2; ++bj)
#pragma unroll
                    for (int n = 0; n < 2; ++n) *(LAS f32x4*)(slab + (wr * 64 + m * 16 + fr) * SLD + bj * 128 + wc * 32 + n * 16 + 4 * fq) = acc[ai][bj][m][n];
            const int grow0 = u.pm * 256 + ai * 128 + wid * 16, gcol = u.pn * 256 + c4;
            f32x4 rr[16];
            if (resid) {
#pragma unroll
                for (int i = 0; i < 16; ++i) rr[i] = *(const f32x4*)(resid + (size_t)(grow0 + i) * DM + gcol);
            } else {
#pragma unroll
                for (int i = 0; i < 16; ++i) { const u32x2 w = *(const u32x2*)(xb_in + (size_t)(grow0 + i) * LDX + gcol);
                    rr[i] = (f32x4){__uint_as_float(w[0] << 16), __uint_as_float(w[0] & 0xffff0000u), __uint_as_float(w[1] << 16), __uint_as_float(w[1] & 0xffff0000u)}; }
            }
            asm volatile("s_waitcnt lgkmcnt(0)" ::: "memory"); __builtin_amdgcn_s_barrier(); asm volatile("" ::: "memory");
            float sq[16];
#pragma unroll
            for (int i = 0; i < 16; ++i) {
                const f32x4 a = *(const LAS f32x4*)(slab + (wid * 16 + i) * SLD + c4);
                const f32x4 v = rr[i] + a;
                if (last) *(f32x4*)(out + (size_t)(grow0 + i) * DM + gcol) = v;
                else { u32x2 w = {cvtpk(v[0], v[1]), cvtpk(v[2], v[3])}; *(u32x2*)(xb + (size_t)(grow0 + i) * LDX + gcol) = w; }
                sq[i] = v[0] * v[0] + v[1] * v[1] + v[2] * v[2] + v[3] * v[3];
            }
            if (!last) {
                const bool b5 = lane & 32, b4 = lane & 16, b3 = lane & 8, b2 = lane & 4;
                float t8[8], t4[4], t2[2];
#pragma unroll
                for (int i = 0; i < 8; ++i) { const float mine = b5 ? sq[8 + i] : sq[i], send = b5 ? sq[i] : sq[8 + i]; t8[i] = mine + __shfl_xor(send, 32); }
#pragma unroll
                for (int i = 0; i < 4; ++i) { const float mine = b4 ? t8[4 + i] : t8[i], send = b4 ? t8[i] : t8[4 + i]; t4[i] = mine + __shfl_xor(send, 16); }
#pragma unroll
                for (int i = 0; i < 2; ++i) { const float mine = b3 ? t4[2 + i] : t4[i], send = b3 ? t4[i] : t4[2 + i]; t2[i] = mine + __shfl_xor(send, 8); }
                float x1 = (b2 ? t2[1] : t2[0]) + __shfl_xor(b2 ? t2[0] : t2[1], 4);
                x1 += __shfl_xor(x1, 2); x1 += __shfl_xor(x1, 1);
                if ((lane & 3) == 0 && !dry) rowsq_next[(size_t)(grow0 + ((lane >> 2) & 15)) * 8 + u.pn] = x1;
            }
            asm volatile("s_waitcnt lgkmcnt(0)" ::: "memory"); __builtin_amdgcn_s_barrier(); asm volatile("" ::: "memory");
        }
    }
};
struct EpiBIn {
    static constexpr bool PERM = true, AFTER_DRAIN = false;
    bf16_t* Q; bf16_t* V; bf16_t* Z; const float* rowsq; const float* gq; const float* gk; LAS float* xbuf;
    __device__ __forceinline__ void operator()(const AccT& acc, const Unit& u, int wr, int wc, int fr, int fq) const {
        const int sec = u.pn >> 3, hp = u.pn & 7;
        int d0 = wc * 32 + 8 * fq; asm volatile("" : "+v"(d0));
        const int row0 = u.pm * 256 + wr * 64 + fr;
        float rstd[2][4];
#pragma unroll
        for (int ai = 0; ai < 2; ++ai)
#pragma unroll
            for (int m = 0; m < 4; ++m) rstd[ai][m] = row_rstd8(rowsq + (size_t)(row0 + ai * 128 + m * 16) * 8);
        if (sec < 2) {
#pragma unroll
            for (int ai = 0; ai < 2; ++ai)
#pragma unroll
                for (int m = 0; m < 4; ++m)
#pragma unroll
                    for (int bj = 0; bj < 2; ++bj) {
                        const f32x4 v0 = acc[ai][bj][m][0] * rstd[ai][m], v1 = acc[ai][bj][m][1] * rstd[ai][m];
                        float ss = 0.f;
#pragma unroll
                        for (int e = 0; e < 4; ++e) ss += v0[e] * v0[e] + v1[e] * v1[e];
                        ss += __shfl_xor(ss, 16); ss += __shfl_xor(ss, 32);
                        if (fq == 0) xbuf[((ai * 128 + wr * 64 + m * 16 + fr) * 2 + bj) * 4 + wc] = ss;
                    }
            asm volatile("s_waitcnt lgkmcnt(0)" ::: "memory"); __builtin_amdgcn_s_barrier(); asm volatile("" ::: "memory");
            const float* gg = sec == 0 ? gq : gk;
            const f32x4 g0 = *(const f32x4*)(gg + d0), g1 = *(const f32x4*)(gg + d0 + 4);
            const float sc = sec == 0 ? QSCALE : 1.f;
            bf16_t* base = Q + (size_t)sec * ((size_t)NH * S * HD);
#pragma unroll
            for (int ai = 0; ai < 2; ++ai)
#pragma unroll
                for (int m = 0; m < 4; ++m)
#pragma unroll
                    for (int bj = 0; bj < 2; ++bj) {
                        const f32x4 p = *(const LAS f32x4*)(xbuf + ((ai * 128 + wr * 64 + m * 16 + fr) * 2 + bj) * 4);
                        const float rs = __builtin_amdgcn_rsqf((p[0] + p[1] + p[2] + p[3]) * (1.f / HD) + EPS) * rstd[ai][m] * sc;
                        const f32x4 v0 = acc[ai][bj][m][0] * rs * g0, v1 = acc[ai][bj][m][1] * rs * g1;
                        const int row = row0 + ai * 128 + m * 16, head = hp * 2 + bj;
                        *(bf16x8*)(base + ((size_t)head * S + row) * HD + d0) = pack8(v0, v1);
                    }
        } else if (sec == 2) {
#pragma unroll
            for (int ai = 0; ai < 2; ++ai)
#pragma unroll
                for (int m = 0; m < 4; ++m)
#pragma unroll
                    for (int bj = 0; bj < 2; ++bj) {
                        const int row = row0 + ai * 128 + m * 16, head = hp * 2 + bj;
                        *(bf16x8*)(V + ((size_t)head * S + row) * HD + d0) = pack8(acc[ai][bj][m][0] * rstd[ai][m], acc[ai][bj][m][1] * rstd[ai][m]);
                    }
        } else {
#pragma unroll
            for (int ai = 0; ai < 2; ++ai)
#pragma unroll
                for (int m = 0; m < 4; ++m)
#pragma unroll
                    for (int bj = 0; bj < 2; ++bj) {
                        f32x4 v0 = acc[ai][bj][m][0] * rstd[ai][m], v1 = acc[ai][bj][m][1] * rstd[ai][m];
#pragma unroll
                        for (int e = 0; e < 4; ++e) { v0[e] = silu(v0[e]); v1[e] = silu(v1[e]); }
                        const int row = row0 + ai * 128 + m * 16;
                        *(bf16x8*)(Z + (size_t)row * LDX + hp * 256 + bj * 128 + d0) = pack8(v0, v1);
                    }
        }
    }
};

__device__ __forceinline__ int uz_row(int n) { return n < AW ? ((n >> 7) * 256 + (n & 127)) : (n < 2 * AW ? (2 * AW + (n - AW)) : (((n - 2 * AW) >> 7) * 256 + 128 + ((n - 2 * AW) & 127))); }
__device__ __forceinline__ void conv_tiles(const float* __restrict__ src, int ld, int K, int ncols, bf16_t* __restrict__ dst, const float* __restrict__ g, LAS float* tile, bool uzmap = false) {
    const int ldd = K + PADK;
    const int tid = threadIdx.x, lk = tid >> 6, ln = tid & 63;
    const int nnt = ncols / 256, ntiles = (K / 64) * nnt;
    f32x4 v[8];
    int t = blockIdx.x;
#define CONV_ISSUE(tt) do { const int n0_ = ((tt) % nnt) * 256, k0_ = ((tt) / nnt) * 64; _Pragma("unroll") for (int i = 0; i < 8; ++i) \
        v[i] = __builtin_nontemporal_load((const f32x4*)(src + (size_t)(k0_ + lk + 8 * i) * ld + n0_ + ln * 4)); } while (0)
    if (t < ntiles) CONV_ISSUE(t);
    for (; t < ntiles; t += gridDim.x) {
        const int n0 = (t % nnt) * 256, k0 = (t / nnt) * 64;
#pragma unroll
        for (int i = 0; i < 8; ++i) { const int k = lk + 8 * i; const float sc = g ? g[k0 + k] : 1.f;
#pragma unroll
            for (int e = 0; e < 4; ++e) tile[k * 257 + e * 64 + ln] = v[i][e] * sc; }
        __syncthreads();
        if (t + (int)gridDim.x < ntiles) CONV_ISSUE(t + gridDim.x);
#pragma unroll
        for (int i = 0; i < 4; ++i) { const int r = tid + 512 * i, kg = r & 7, m = (r >> 3) & 63, e = r >> 9, n = 4 * m + e;
            f32x4 a, b;
#pragma unroll
            for (int j = 0; j < 4; ++j) { a[j] = tile[(kg * 8 + j) * 257 + e * 64 + m]; b[j] = tile[(kg * 8 + 4 + j) * 257 + e * 64 + m]; }
            *(bf16x8*)(dst + (size_t)(uzmap ? uz_row(n0 + n) : (n0 + n)) * ldd + k0 + kg * 8) = pack8(a, b); }
        __syncthreads();
    }
#undef CONV_ISSUE
}
__device__ __forceinline__ void phase0(const Params& p, LAS unsigned char* lds) {
    LAS float* tile = (LAS float*)lds;
    unsigned char* ws = p.ws;
    const int tid = threadIdx.x, wid = tid >> 6, lane = tid & 63;
    const int gtid = blockIdx.x * 512 + tid, gsz = gridDim.x * 512;
    { bf16_t* wsb = (bf16_t*)(ws + WS_WSB);
      for (int i = gtid; i < 2 * NG * CH * CH / 4; i += gsz) { const int e = i * 4, tt = (e >> 7) & 127, s0 = e & 127;
          const f32x4 v = *(const f32x4*)(p.a_w_s + e);
          u32x2 w = {cvtpk(s0 <= tt ? v[0] : 0.f, s0 + 1 <= tt ? v[1] : 0.f), cvtpk(s0 + 2 <= tt ? v[2] : 0.f, s0 + 3 <= tt ? v[3] : 0.f)};
          *(u32x2*)(wsb + e) = w; } }
    for (int l = 0; l < 2; ++l) { bf16_t* wf = (bf16_t*)(ws + WS_WBF + l * SZ_WBF);
        for (int i = gtid; i < 32 * DM; i += gsz) { const int j = i / DM, k = i % DM;
            const float v = j < 16 ? p.b_w_in[(size_t)l * DM * NBIN_LD + (size_t)k * NBIN_LD + NBIN + j] * p.b_norm_g[l * DM + k] : 0.f;
            wf[i] = (bf16_t)(cvtpk(v, 0.f) & 0xffffu); } }
    for (int l = 1; l >= 0; --l) {
        conv_tiles(p.b_w_out + (size_t)l * DM * DM, DM, DM, DM, (bf16_t*)(ws + WS_WBOUT + l * SZ_WBOUT), nullptr, tile);
        conv_tiles(p.b_w_in + (size_t)l * DM * NBIN_LD, NBIN_LD, DM, NBIN, (bf16_t*)(ws + WS_WBIN + l * SZ_WBIN), p.b_norm_g + l * DM, tile);
        conv_tiles(p.a_w_out + (size_t)l * AW * DM, DM, AW, DM, (bf16_t*)(ws + WS_WAOUT + l * SZ_WAOUT), nullptr, tile);
        conv_tiles(p.a_w_in + (size_t)l * DM * NAIN, NAIN, DM, NAIN, (bf16_t*)(ws + WS_WAIN + l * SZ_WAIN), p.a_norm_g + l * DM, tile, true);
    }
    { bf16_t* xb = (bf16_t*)(ws + WS_XB); float* rsq = (float*)(ws + WS_ROWSQ);
      for (int row = blockIdx.x * 8 + wid; row < S; row += gridDim.x * 8) {
          const float* xr = p.x + (size_t)row * DM; f32x4 v[8]; float ss = 0.f;
#pragma unroll
          for (int i = 0; i < 8; ++i) { v[i] = *(const f32x4*)(xr + i * 256 + lane * 4); ss += v[i][0] * v[i][0] + v[i][1] * v[i][1] + v[i][2] * v[i][2] + v[i][3] * v[i][3]; }
          ss = wave_sum(ss);
#pragma unroll
          for (int i = 0; i < 8; ++i) { u32x2 w = {cvtpk(v[i][0], v[i][1]), cvtpk(v[i][2], v[i][3])}; *(u32x2*)(xb + (size_t)row * LDX + i * 256 + lane * 4) = w; }
          if (lane < 8) rsq[(size_t)row * 8 + lane] = lane == 0 ? ss : 0.f;
      } }
}

constexpr int SHM_V = 64 * 128 * 2, SHM_K = 64 * 128 * 2;
__device__ __forceinline__ int v_st(int k, int c) { const int kk = (k & ~0xC) | ((k & 4) << 1) | ((k & 8) >> 1); return ((kk >> 3) * 4 + (c >> 5)) * 512 + ((kk & 7) * 32 + (c & 31)) * 2; }
__device__ __forceinline__ int v_rd_base(int lane) { return ((lane & 3) << 3) | (((lane >> 2) & 3) << 6) | (((lane >> 4) & 1) << 5) | (((lane >> 5) & 1) << 8); }
constexpr int v_rd_off(int d0, int ks, int half) { return d0 * 512 + ks * 4096 + half * 2048; }
__device__ __forceinline__ int crow(int r, int hi) { return (r & 3) + 8 * (r >> 2) + 4 * hi; }
#define SBAR() __builtin_amdgcn_sched_barrier(0)
template <int VOFF>
__device__ __forceinline__ void pv_tile(f32x16* o, int vb0, bf16x8 pa0, bf16x8 pa1, bf16x8 pa2, bf16x8 pa3) {
#define TRRD(dst, off) asm volatile("ds_read_b64_tr_b16 %0, %1 offset:%2" : "=&v"(dst) : "v"(vb0), "i"(off) : "memory")
#define PV_D0(d0) do { s16x4 l0, l1, l2, l3, h0, h1, h2, h3; constexpr int b_ = VOFF + v_rd_off(d0, 0, 0); \
        TRRD(l0, b_); TRRD(h0, b_ + 2048); TRRD(l1, b_ + 4096); TRRD(h1, b_ + 6144); TRRD(l2, b_ + 8192); TRRD(h2, b_ + 10240); TRRD(l3, b_ + 12288); TRRD(h3, b_ + 14336); \
        asm volatile("s_waitcnt lgkmcnt(0)" ::: "memory"); SBAR(); \
        o[d0] = __builtin_amdgcn_mfma_f32_32x32x16_bf16((bf16x8){l0[0], l0[1], l0[2], l0[3], h0[0], h0[1], h0[2], h0[3]}, pa0, o[d0], 0, 0, 0);   \
        o[d0] = __builtin_amdgcn_mfma_f32_32x32x16_bf16((bf16x8){l1[0], l1[1], l1[2], l1[3], h1[0], h1[1], h1[2], h1[3]}, pa1, o[d0], 0, 0, 0);   \
        o[d0] = __builtin_amdgcn_mfma_f32_32x32x16_bf16((bf16x8){l2[0], l2[1], l2[2], l2[3], h2[0], h2[1], h2[2], h2[3]}, pa2, o[d0], 0, 0, 0);   \
        o[d0] = __builtin_amdgcn_mfma_f32_32x32x16_bf16((bf16x8){l3[0], l3[1], l3[2], l3[3], h3[0], h3[1], h3[2], h3[3]}, pa3, o[d0], 0, 0, 0); } while (0)
    PV_D0(0); PV_D0(1); PV_D0(2); PV_D0(3);
#undef PV_D0
#undef TRRD
}

__device__ __forceinline__ void mix_phase(const Params& p, int l, char* lds, const int tid) {
    unsigned char* ws = p.ws;
    const bf16_t* U = (const bf16_t*)(ws + WS_U); const bf16_t* Vb = (const bf16_t*)(ws + WS_V); bf16_t* Y = (bf16_t*)(ws + WS_Y);
    const float* vsq = (const float*)(ws + WS_VSQ) + (size_t)l * S * 16;
    const float* gv = p.a_v_norm_g + l * AW; const bf16_t* wsb = (const bf16_t*)(ws + WS_WSB) + (size_t)l * NG * CH * CH; const float* bsp = p.a_b_s + l * NG * CH;
    const int wid = __builtin_amdgcn_readfirstlane(tid >> 6), lane = tid & 63, r32 = lane & 31, hi = lane >> 5;
    const int sr = tid >> 4, sc = (tid & 15) * 8;
    const int wt = wid >> 1, wd = wid & 1;
    const int vb0 = (int)(uintptr_t)lds + v_rd_base(lane) + wd * SHM_V;
    char* stg = lds + 4 * SHM_V + wid * (32 * 272);
    for (int u0 = blockIdx.x; u0 < (S / CH) * NG; u0 += gridDim.x) {
        const int it = u0 >> 8, bb = u0 & 255, xcd = bb & 7, idx = bb >> 3;
        const int g = idx & 15, c = xcd * 8 + (idx >> 4) + 2 * it;
        u32x4 raw[8]; float rs[4];
#pragma unroll
        for (int st = 0; st < 2; ++st)
#pragma unroll
            for (int i = 0; i < 2; ++i) { const int row = c * CH + st * 64 + i * 32 + sr;
                { const f32x4 q0 = *(const f32x4*)(vsq + (size_t)row * 16), q1 = *(const f32x4*)(vsq + (size_t)row * 16 + 4), q2 = *(const f32x4*)(vsq + (size_t)row * 16 + 8), q3 = *(const f32x4*)(vsq + (size_t)row * 16 + 12);
                  rs[st * 2 + i] = ((((q0[0] + q0[1]) + (q0[2] + q0[3])) + ((q1[0] + q1[1]) + (q1[2] + q1[3]))) + (((q2[0] + q2[1]) + (q2[2] + q2[3])) + ((q3[0] + q3[1]) + (q3[2] + q3[3])))); }
#pragma unroll
                for (int dh = 0; dh < 2; ++dh) raw[(st * 2 + i) * 2 + dh] = __builtin_nontemporal_load((const u32x4*)(Vb + (size_t)row * LDA4 + g * GD + dh * 128 + sc)); }
        const int t = wt * 32 + r32;
        bf16x8 pa[8];
#pragma unroll
        for (int j = 0; j < 8; ++j) pa[j] = *(const bf16x8*)(wsb + ((size_t)g * CH + t) * CH + j * 16 + hi * 8);
        u32x4 uu[8];
        { int eo = (c * CH + wt * 32 + (lane >> 4)) * LDA4 + g * GD + wd * 128 + (lane & 15) * 8; asm volatile("" : "+v"(eo));
#pragma unroll
          for (int i = 0; i < 8; ++i) uu[i] = __builtin_nontemporal_load((const u32x4*)(U + eo + i * 4 * LDA4)); }
        const float bias = bsp[g * CH + t];
#pragma unroll
        for (int dh = 0; dh < 2; ++dh) {
            const f32x4 g0 = *(const f32x4*)(gv + g * GD + dh * 128 + sc), g1 = *(const f32x4*)(gv + g * GD + dh * 128 + sc + 4);
#pragma unroll
            for (int st = 0; st < 2; ++st)
#pragma unroll
                for (int i = 0; i < 2; ++i) {
                    const float r_ = __builtin_amdgcn_rsqf(rs[st * 2 + i] * (1.f / AW) + EPS);
                    const u32x4 w = raw[(st * 2 + i) * 2 + dh];
                    f32x4 a, b;
                    a[0] = __uint_as_float(w[0] << 16) * r_ * g0[0]; a[1] = __uint_as_float(w[0] & 0xffff0000u) * r_ * g0[1];
                    a[2] = __uint_as_float(w[1] << 16) * r_ * g0[2]; a[3] = __uint_as_float(w[1] & 0xffff0000u) * r_ * g0[3];
                    b[0] = __uint_as_float(w[2] << 16) * r_ * g1[0]; b[1] = __uint_as_float(w[2] & 0xffff0000u) * r_ * g1[1];
                    b[2] = __uint_as_float(w[3] << 16) * r_ * g1[2]; b[3] = __uint_as_float(w[3] & 0xffff0000u) * r_ * g1[3];
                    *(bf16x8*)(lds + (st * 2 + dh) * SHM_V + v_st(i * 32 + sr, sc)) = pack8(a, b);
                }
        }
        __syncthreads();
        f32x16 o[4] = {};
        pv_tile<0>(o, vb0, pa[0], pa[1], pa[2], pa[3]);
        if (wt >= 2) pv_tile<2 * SHM_V>(o, vb0, pa[4], pa[5], pa[6], pa[7]);
#pragma unroll
        for (int q = 0; q < 16; ++q) { const int d0 = q >> 2, j = q & 3;
            u32x2 w = {cvtpk(o[d0][4 * j + 0] + bias, o[d0][4 * j + 1] + bias), cvtpk(o[d0][4 * j + 2] + bias, o[d0][4 * j + 3] + bias)};
            *(u32x2*)(stg + r32 * 272 + (32 * d0 + 8 * j + 4 * hi) * 2) = w; }
        asm volatile("s_waitcnt lgkmcnt(0)" ::: "memory");
        { int eo = (c * CH + wt * 32 + (lane >> 4)) * LDA4 + g * GD + wd * 128 + (lane & 15) * 8; asm volatile("" : "+v"(eo));
#pragma unroll
          for (int i = 0; i < 8; ++i) {
              const u32x4 m = *(const u32x4*)(stg + ((lane >> 4) + 4 * i) * 272 + (lane & 15) * 16);
              u32x4 w;
#pragma unroll
              for (int e = 0; e < 4; ++e) {
                  const float lo = __uint_as_float(m[e] << 16) * __uint_as_float(uu[i][e] << 16);
                  const float hh = __uint_as_float(m[e] & 0xffff0000u) * __uint_as_float(uu[i][e] & 0xffff0000u);
                  w[e] = cvtpk(lo, hh); }
              *(u32x4*)(Y + eo + i * 4 * LDA4) = w; } }
        __syncthreads();
    }
}

__device__ __forceinline__ void flog_phase(const Params& p, int l, LAS unsigned char* lds, const int tid) {
    unsigned char* ws = p.ws;
    const bf16_t* xb = (const bf16_t*)(ws + WS_XB); const bf16_t* wf = (const bf16_t*)(ws + WS_WBF + l * SZ_WBF);
    const float* rowsq = (const float*)(ws + WS_ROWSQ) + (size_t)(2 * l + 1) * S * 8; float* flog = (float*)(ws + WS_FLOG);
    const int wid = __builtin_amdgcn_readfirstlane(tid >> 6), lane = tid & 63, r32 = lane & 31, hi = lane >> 5;
    LAS float* part = (LAS float*)lds;
    for (int rb = blockIdx.x; rb < S / 32; rb += gridDim.x) {
        const int row0 = rb * 32;
        f32x16 acc = {};
        const bf16_t* ap = xb + (size_t)(row0 + r32) * LDX + wid * 256 + hi * 8;
        const bf16_t* bp = wf + (size_t)r32 * DM + wid * 256 + hi * 8;
#pragma unroll
        for (int j = 0; j < 16; ++j) {
            const bf16x8 a = *(const bf16x8*)(ap + j * 16), b = *(const bf16x8*)(bp + j * 16);
            acc = __builtin_amdgcn_mfma_f32_32x32x16_bf16(a, b, acc, 0, 0, 0);
        }
        if (r32 < 16) {
#pragma unroll
            for (int r = 0; r < 16; ++r) part[(wid * 32 + crow(r, hi)) * 16 + r32] = acc[r];
        }
        __syncthreads();
        { const int tok = tid >> 4, h = tid & 15; float s = 0.f;
#pragma unroll
          for (int w = 0; w < 8; ++w) s += part[(w * 32 + tok) * 16 + h];
          const int row = row0 + tok;
          const float xv = s * row_rstd8(rowsq + (size_t)row * 8) + p.b_f_bias[l * NH + h];
          const float ls = fminf(xv, 0.f) - log1pf(__expf(-fabsf(xv)));
          flog[(size_t)h * S + row] = ls; }
        __syncthreads();
    }
}

namespace att {
constexpr int D = 128, NW = 8, QBLK = 32, KVBLK = 64, QB = NW * QBLK;
constexpr int OFF_WS = 2 * SHM_V + 2 * SHM_K, OFF_CUM = OFF_WS + NW * 64 * 4, OFF_WT = OFF_CUM + S * 4, OFF_GL = OFF_WT + 64, OFF_FAC = OFF_GL + 64 * 8, OFF_M = OFF_FAC + 64 * 4, LDS_END = OFF_M + 64;
#define KSWZ(row, colB) ((row) * 256 + ((colB) ^ (((row) & 7) << 4)))
__device__ __forceinline__ bf16x8 load8(const bf16_t* p) { return *reinterpret_cast<const bf16x8*>(p); }
__device__ __forceinline__ void mask_tile(f32x16& p0, f32x16& p1, int dq) {
    const float NEG = -__builtin_inff();
#pragma unroll
    for (int r = 0; r < 16; ++r) {
        const int c = (r & 3) + 8 * (r >> 2);
        if (dq - c < 0) p0[r] = NEG;
        if (dq - c - 32 < 0) p1[r] = NEG;
    }
}
__device__ __forceinline__ void partialSM(f32x16& p0) {
#pragma unroll
    for (int r = 0; r < 16; ++r) p0[r] = __builtin_amdgcn_exp2f(p0[r]);
}
__device__ __forceinline__ void finishSM(f32x16& p0, f32x16& p1, float alpha, float& l_reg, bf16x8& pa0, bf16x8& pa1, bf16x8& pa2, bf16x8& pa3) {
#pragma unroll
    for (int r = 0; r < 16; ++r) p1[r] = __builtin_amdgcn_exp2f(p1[r]);
    float ps = 0;
#pragma unroll
    for (int r = 0; r < 16; ++r) ps += p0[r];
#pragma unroll
    for (int r = 0; r < 16; ++r) ps += p1[r];
    { auto rr = __builtin_amdgcn_permlane32_swap(__float_as_uint(ps), __float_as_uint(ps), false, false);
      ps = __uint_as_float(rr[0]) + __uint_as_float(rr[1]); }
    l_reg = l_reg * alpha + ps;
#define PK4(P, B_, OUT) do { unsigned a0 = cvtpk(P[B_+0], P[B_+1]), a1 = cvtpk(P[B_+2], P[B_+3]);                          \
        unsigned b0 = cvtpk(P[B_+4], P[B_+5]), b1 = cvtpk(P[B_+6], P[B_+7]);                                             \
        auto r0 = __builtin_amdgcn_permlane32_swap(a0, b0, false, false); auto r1 = __builtin_amdgcn_permlane32_swap(a1, b1, false, false); \
        u32x4 w = {r0[0], r1[0], r0[1], r1[1]}; OUT = *reinterpret_cast<bf16x8*>(&w); } while (0)
    PK4(p0, 0, pa0); PK4(p0, 8, pa1); PK4(p1, 0, pa2); PK4(p1, 8, pa3);
#undef PK4
}
template <int KB>
__device__ __forceinline__ void qkt(f32x16& p0, f32x16& p1, const char* K_lds, const char* exb, unsigned lmask, bf16x8 qx, int r32, int hi, const bf16x8* qr) {
    { const unsigned e0 = *reinterpret_cast<const unsigned*>(exb) & lmask, e1 = *reinterpret_cast<const unsigned*>(exb + 128) & lmask, one = 0x3F80u & lmask;
      u32x4 w0 = {e0, one, 0u, 0u}, w1 = {e1, one, 0u, 0u};
      const f32x16 z = {};
      p0 = __builtin_amdgcn_mfma_f32_32x32x16_bf16(*reinterpret_cast<bf16x8*>(&w0), qx, z, 0, 0, 0);
      p1 = __builtin_amdgcn_mfma_f32_32x32x16_bf16(*reinterpret_cast<bf16x8*>(&w1), qx, z, 0, 0, 0); }
    const char* kb[4];
#pragma unroll
    for (int dd = 0; dd < 4; ++dd) kb[dd] = K_lds + KB * SHM_K + KSWZ(r32, (dd * 16 + hi * 8) * 2);
#pragma unroll
    for (int d0 = 0; d0 < 8; ++d0) { const char* a = kb[d0 & 3] + (d0 >> 2) * 128;
        bf16x8 b0 = *reinterpret_cast<const bf16x8*>(a);
        bf16x8 b1 = *reinterpret_cast<const bf16x8*>(a + 32 * 256);
        p0 = __builtin_amdgcn_mfma_f32_32x32x16_bf16(b0, qr[d0], p0, 0, 0, 0);
        p1 = __builtin_amdgcn_mfma_f32_32x32x16_bf16(b1, qr[d0], p1, 0, 0, 0); }
}
struct BlockRef { const bf16_t* Q; const bf16_t* K; const bf16_t* V; const bf16_t* Zg; bf16_t* Y; int P0; };
struct Seam { bf16x8 qr[8]; bf16x8 st_v0, st_v1, st_k0, st_k1; };
#define ROW(p, k0, rr) ((p) + (size_t)((k0) + (rr)) * D + sc)
#define VMW() asm volatile("s_waitcnt vmcnt(0)" ::: "memory")
#define VMWN(n) asm volatile("s_waitcnt vmcnt(%0)" :: "i"(n) : "memory")
#define SLOAD_H(Kp, Vp, k0) do { S_.st_v0 = load8(ROW(Vp, k0, sr)); S_.st_v1 = load8(ROW(Vp, k0, 32 + sr));              \
                         S_.st_k0 = load8(ROW(Kp, k0, sr)); S_.st_k1 = load8(ROW(Kp, k0, 32 + sr)); } while (0)
#define SWRITE_HK(bf) do { *(bf16x8*)(K_lds + (bf) * SHM_K + kws) = S_.st_k0; *(bf16x8*)(K_lds + (bf) * SHM_K + kws + 32 * 256) = S_.st_k1; } while (0)
#define SWRITE_HV(bf) do { *(bf16x8*)(V_lds + (bf) * SHM_V + vst0) = S_.st_v0; *(bf16x8*)(V_lds + (bf) * SHM_V + vst1) = S_.st_v1; } while (0)
#define SWRITE_H(bf) do { SWRITE_HV(bf); SWRITE_HK(bf); } while (0)
__device__ __forceinline__ void prime_issue(const BlockRef& cur, Seam& S_, const int tid) {
    const int wid = __builtin_amdgcn_readfirstlane(tid >> 6), lane = tid & 63, r32 = lane & 31, hi = lane >> 5;
    const int sr = tid >> 4, sc = (tid & 15) * 8;
#pragma unroll
    for (int d0 = 0; d0 < 8; ++d0) S_.qr[d0] = load8(cur.Q + (size_t)(wid * QBLK + r32) * D + d0 * 16 + hi * 8);
    SLOAD_H(cur.K, cur.V, 0);
}
__device__ __forceinline__ void prime_finish(char* lds, Seam& S_, const int tid) {
    const int sr = tid >> 4, sc = (tid & 15) * 8, kws = KSWZ(sr, sc * 2); char* K_lds = lds + 2 * SHM_V;
    VMW(); SWRITE_HK(0);
    __syncthreads();
}
__device__ __forceinline__ void prime(const BlockRef& cur, char* lds, Seam& S_, const int tid) {
    const int wid = __builtin_amdgcn_readfirstlane(tid >> 6), lane = tid & 63, r32 = lane & 31, hi = lane >> 5;
    const int sr = tid >> 4, sc = (tid & 15) * 8, kws = KSWZ(sr, sc * 2); char* K_lds = lds + 2 * SHM_V;
#pragma unroll
    for (int d0 = 0; d0 < 8; ++d0) S_.qr[d0] = load8(cur.Q + (size_t)(wid * QBLK + r32) * D + d0 * 16 + hi * 8);
    SLOAD_H(cur.K, cur.V, 0); VMW(); SWRITE_HK(0);
    __syncthreads();
}
__device__ __forceinline__ void block(const BlockRef& cur, char* lds, Seam& S_, const int tid) {
    const int wid = __builtin_amdgcn_readfirstlane(tid >> 6), lane = tid & 63, r32 = lane & 31, hi = lane >> 5;
    const int NT = (cur.P0 + QB - 1) / KVBLK + 1;
    const int qlo = cur.P0 + wid * QBLK, qm = qlo + r32 - 4 * hi;
    char* V_lds = lds; char* K_lds = lds + 2 * SHM_V;
    const char* cum_l = lds + OFF_CUM + r32 * 4;
    const unsigned lmask = hi ? 0u : 0xffffffffu;
    bf16x8 qx; { const unsigned mb = *(const unsigned*)(lds + OFF_M + 4); u32x4 w = {0x3F803F80u & lmask, mb & lmask, 0u, 0u}; qx = *reinterpret_cast<bf16x8*>(&w); }
    const float* facL = (const float*)(lds + OFF_FAC);
    float l_reg = 0; f32x16 o[4] = {};
    const int sr = tid >> 4, sc = (tid & 15) * 8, vst0 = v_st(sr, sc), vst1 = v_st(32 + sr, sc), kws = KSWZ(sr, sc * 2);
    const int vb0 = (int)(uintptr_t)V_lds + v_rd_base(lane);
    const bf16_t* Kh = cur.K; const bf16_t* Vh = cur.V;
#define RESC(a) do { if (__any((a) < 1.f)) {                                                                              \
                     for (int d_ = 0; d_ < 4; ++d_) for (int r = 0; r < 16; ++r) o[d_][r] *= (a); } } while (0)
#define KBASE(t) ((t) * KVBLK)
#define MASKT(P0_, P1_, t) do { const int kb_ = KBASE(t); if (kb_ + KVBLK - 1 > qlo) mask_tile(P0_, P1_, qm - kb_); } while (0)
#define QKT(KB, PX0, PX1, t) qkt<KB>(PX0, PX1, K_lds, cum_l + KBASE(t) * 4, lmask, qx, r32, hi, S_.qr)
#define ALPHA(KB, t) (((KB) == 0 && (t) > 0) ? facL[(t) >> 1] : 1.f)
    f32x16 pA0, pA1, pB0, pB1; float alA, alB; bf16x8 pa0, pa1, pa2, pa3;
    SWRITE_HV(0); SBAR();
    if (NT > 1) { SLOAD_H(Kh, Vh, KBASE(1)); }
    SBAR(); QKT(0, pA0, pA1, 0);
    MASKT(pA0, pA1, 0); partialSM(pA0); alA = 1.f;
    if (NT > 1) { VMW(); SWRITE_H(1); }
    __syncthreads();
#define HALF_STEP(PX0, PX1, alX, PY0, PY1, alY, t, KB, VOFF, SB) do {                                                      \
        SBAR(); QKT(KB, PX0, PX1, t);                                                                                           \
        finishSM(PY0, PY1, alY, l_reg, pa0, pa1, pa2, pa3); SBAR();                                                           \
        if ((t) + 1 < NT) { SLOAD_H(Kh, Vh, KBASE((t) + 1)); SBAR(); }                                                         \
        pv_tile<VOFF>(o, vb0, pa0, pa1, pa2, pa3); MASKT(PX0, PX1, (t)); partialSM(PX0); alX = ALPHA(KB, t);               \
        __syncthreads();                                                                                                      \
        if ((t) + 1 < NT) { VMW(); SWRITE_H(SB); }                                                                            \
        RESC(alX); __syncthreads(); } while (0)
    for (int t = 1; t + 1 < NT; t += 2) {
        HALF_STEP(pB0, pB1, alB, pA0, pA1, alA, t, 1, 0, 0);
        HALF_STEP(pA0, pA1, alA, pB0, pB1, alB, t + 1, 0, SHM_V, 1);
    }
    const bool even = (NT & 1) == 0;
    if (even) { SBAR(); QKT(1, pB0, pB1, NT - 1); SBAR(); }
    finishSM(pA0, pA1, alA, l_reg, pa0, pa1, pa2, pa3); SBAR();
    pv_tile<0>(o, vb0, pa0, pa1, pa2, pa3);
    if (even) { MASKT(pB0, pB1, NT - 1); partialSM(pB0); alB = 1.f; __syncthreads();
        finishSM(pB0, pB1, alB, l_reg, pa0, pa1, pa2, pa3); SBAR(); pv_tile<SHM_V>(o, vb0, pa0, pa1, pa2, pa3); }
    SBAR();
    {
        const float inv = __builtin_amdgcn_rcpf(l_reg);
        int ln = lane; asm volatile("" : "+v"(ln));
        const int lr = ln >> 4, lc = ln & 15, r32e = ln & 31, hie = ln >> 5;
        const int eo = (wid * QBLK + lr) * LDX + lc * 8;
        u32x4 zz[8];
#pragma unroll
        for (int i = 0; i < 8; ++i) zz[i] = __builtin_nontemporal_load((const u32x4*)(cur.Zg + eo + i * 4 * LDX));
        __syncthreads();
        char* stg = lds + wid * 8192;
        { char* wp = stg + r32e * 256 + hie * 8; const int sw = r32e & 15;
#pragma unroll
          for (int q = 0; q < 16; ++q) { const int d0 = q >> 2, j = q & 3;
              u32x2 w = {cvtpk(o[d0][4 * j + 0] * inv, o[d0][4 * j + 1] * inv), cvtpk(o[d0][4 * j + 2] * inv, o[d0][4 * j + 3] * inv)};
              *(u32x2*)(wp + (((4 * d0 + j) ^ sw) << 4)) = w; } }
        asm volatile("s_waitcnt lgkmcnt(0)" ::: "memory");
#pragma unroll
        for (int i = 0; i < 8; ++i) { const int row = lr + 4 * i;
            const u32x4 m = *(const u32x4*)(stg + row * 256 + (((lc ^ (row & 15))) << 4));
            u32x4 w;
#pragma unroll
            for (int e = 0; e < 4; ++e) {
                const float lo = __uint_as_float(m[e] << 16) * __uint_as_float(zz[i][e] << 16);
                const float hh = __uint_as_float(m[e] & 0xffff0000u) * __uint_as_float(zz[i][e] & 0xffff0000u);
                w[e] = cvtpk(lo, hh); }
            *(u32x4*)(cur.Y + eo + i * 4 * LDX) = w; }
    }
    __syncthreads();
#undef RESC
#undef KBASE
#undef MASKT
#undef QKT
#undef ALPHA
#undef HALF_STEP
}
#undef ROW
#undef VMW
#undef VMWN
#undef SLOAD_H
#undef SWRITE_HK
#undef SWRITE_HV
#undef SWRITE_H
}

__device__ __forceinline__ void attn_phase(const Params& p, int lyr, char* lds) {
    unsigned char* ws = p.ws;
    const bf16_t* Q = (const bf16_t*)(ws + WS_U); const bf16_t* Kk = Q + (size_t)NH * S * HD; const bf16_t* V = (const bf16_t*)(ws + WS_V);
    const bf16_t* Z = (const bf16_t*)(ws + WS_Z); bf16_t* Y = (bf16_t*)(ws + WS_Y);
    const float* flog = (const float*)(ws + WS_FLOG);
    float* cumL = (float*)(lds + att::OFF_CUM); double* wtot = (double*)(lds + att::OFF_WT);
    for (int item = blockIdx.x; item < NH * 16; item += gridDim.x) {
        int tid = threadIdx.x; asm volatile("" : "+v"(tid));
        const int wid = tid >> 6, lane = tid & 63;
        const int xcd = item & 7, slot = (item >> 3) & 31;
        const int h = 2 * xcd + (slot >> 4), x = slot & 15;
        att::Seam sm;
        att::BlockRef b1, b2;
        const int P1 = (31 - x) * 256, P2 = x * 256;
        const bf16_t* Qh = Q + (size_t)h * S * HD; const bf16_t* Kh = Kk + (size_t)h * S * HD; const bf16_t* Vh = V + (size_t)h * S * HD;
        b1.Q = Qh + (size_t)P1 * HD; b1.K = Kh; b1.V = Vh; b1.Zg = Z + (size_t)P1 * LDX + h * HD; b1.Y = Y + (size_t)P1 * LDX + h * HD; b1.P0 = P1;
        b2.Q = Qh + (size_t)P2 * HD; b2.K = Kh; b2.V = Vh; b2.Zg = Z + (size_t)P2 * LDX + h * HD; b2.Y = Y + (size_t)P2 * LDX + h * HD; b2.P0 = P2;
        att::prime_issue(b1, sm, tid);
        { const float* fl = flog + (size_t)h * S + tid * 16;
          const f32x4 a0 = *(const f32x4*)fl, a1 = *(const f32x4*)(fl + 4), a2 = *(const f32x4*)(fl + 8), a3 = *(const f32x4*)(fl + 12);
          double* gl = (double*)(lds + att::OFF_GL); float* facL = (float*)(lds + att::OFF_FAC); float* Mv = (float*)(lds + att::OFF_M);
          if (wid == 0) { const float* gq = p.b_q_norm_g + lyr * HD; const float* gk = p.b_k_norm_g + lyr * HD;
              float m = fmaxf(fabsf(gq[lane] * gk[lane]), fabsf(gq[lane + 64] * gk[lane + 64]));
#pragma unroll
              for (int o = 32; o; o >>= 1) m = fmaxf(m, __shfl_xor(m, o));
              if (lane == 0) { const float Mf = m * (11.313708498984761f * LOG2E) + 1.f;
                  unsigned ub = __float_as_uint(Mf); ub = (ub + 0xffffu) & 0xffff0000u;
                  ((unsigned*)Mv)[1] = (ub >> 16) | 0x8000u; } }
          double s = 0.0;
#pragma unroll
          for (int e = 0; e < 4; ++e) s += (double)a0[e];
#pragma unroll
          for (int e = 0; e < 4; ++e) s += (double)a1[e];
#pragma unroll
          for (int e = 0; e < 4; ++e) s += (double)a2[e];
#pragma unroll
          for (int e = 0; e < 4; ++e) s += (double)a3[e];
          double inc = s;
#pragma unroll
          for (int o = 1; o < 64; o <<= 1) { const double t = __shfl_up(inc, o); if (lane >= o) inc += t; }
          if (lane == 63) wtot[wid] = inc;
          __syncthreads();
          double run = inc - s;
          for (int w = 0; w < wid; ++w) run += wtot[w];
          if ((tid & 7) == 7) gl[tid >> 3] = run + s;
          __syncthreads();
          const double cl = gl[tid >> 3];
          if (tid < 64) facL[tid] = tid == 0 ? 1.f : __builtin_amdgcn_exp2f((float)((gl[tid] - gl[tid - 1]) * 1.4426950408889634));
          f32x4 o4;
#pragma unroll
          for (int e = 0; e < 4; ++e) { run += (double)a0[e]; const float ev = (float)((cl - run) * 1.4426950408889634); const unsigned h1 = cvtpk(ev, 0.f) & 0xffffu;
              const unsigned h2 = cvtpk(ev - __uint_as_float(h1 << 16), 0.f) & 0xffffu; o4[e] = __uint_as_float(h1 | (h2 << 16)); }
          *(f32x4*)(cumL + tid * 16) = o4;
#pragma unroll
          for (int e = 0; e < 4; ++e) { run += (double)a1[e]; const float ev = (float)((cl - run) * 1.4426950408889634); const unsigned h1 = cvtpk(ev, 0.f) & 0xffffu;
              const unsigned h2 = cvtpk(ev - __uint_as_float(h1 << 16), 0.f) & 0xffffu; o4[e] = __uint_as_float(h1 | (h2 << 16)); }
          *(f32x4*)(cumL + tid * 16 + 4) = o4;
#pragma unroll
          for (int e = 0; e < 4; ++e) { run += (double)a2[e]; const float ev = (float)((cl - run) * 1.4426950408889634); const unsigned h1 = cvtpk(ev, 0.f) & 0xffffu;
              const unsigned h2 = cvtpk(ev - __uint_as_float(h1 << 16), 0.f) & 0xffffu; o4[e] = __uint_as_float(h1 | (h2 << 16)); }
          *(f32x4*)(cumL + tid * 16 + 8) = o4;
#pragma unroll
          for (int e = 0; e < 4; ++e) { run += (double)a3[e]; const float ev = (float)((cl - run) * 1.4426950408889634); const unsigned h1 = cvtpk(ev, 0.f) & 0xffffu;
              const unsigned h2 = cvtpk(ev - __uint_as_float(h1 << 16), 0.f) & 0xffffu; o4[e] = __uint_as_float(h1 | (h2 << 16)); }
          *(f32x4*)(cumL + tid * 16 + 12) = o4;
          __syncthreads(); }
        att::prime_finish(lds, sm, tid);
        att::block(b1, lds, sm, tid);
        att::prime(b2, lds, sm, tid);
        att::block(b2, lds, sm, tid);
        asm volatile("s_waitcnt vmcnt(0)" ::: "memory");
        __syncthreads();
    }
}

constexpr int LDS_XBUF = pg8::STAGE_BYTES;
constexpr int LDS_BYTES = pg8::STAGE_BYTES + 8192;
static_assert(att::LDS_END <= LDS_BYTES, "lds");
constexpr int NPHASES = 13;


__device__ __forceinline__ void grid_bar(unsigned* ctr, unsigned& epoch) {
    asm volatile("s_waitcnt vmcnt(0) lgkmcnt(0)" ::: "memory");
    __syncthreads();
    epoch += gridDim.x;
    if (threadIdx.x == 0) {
        __builtin_amdgcn_fence(__ATOMIC_RELEASE, "agent");
        asm volatile("s_waitcnt vmcnt(0)" ::: "memory");
        __hip_atomic_fetch_add(ctr, 1u, __ATOMIC_RELAXED, __HIP_MEMORY_SCOPE_AGENT);
        while (__hip_atomic_load(ctr, __ATOMIC_RELAXED, __HIP_MEMORY_SCOPE_AGENT) < epoch) __builtin_amdgcn_s_sleep(1);
        __builtin_amdgcn_fence(__ATOMIC_ACQUIRE, "agent");
        asm volatile("s_waitcnt vmcnt(0)" ::: "memory");
    }
    __syncthreads();
}

template <int KIND>
__device__ __forceinline__ void run_layer_phase(const Params& p, int l, unsigned char* smem, int dry = 0) {
    LAS unsigned char* lds = (LAS unsigned char*)smem;
    unsigned char* ws = p.ws;
    bf16_t* xb = (bf16_t*)(ws + WS_XB);
    float* rowsq = (float*)(ws + WS_ROWSQ);
    pg8::StaticOrder so;
    int tid = threadIdx.x; asm volatile("" : "+v"(tid));
    if constexpr (KIND == 0) {
        const int L = 2 * l;
        pg8::Gemm g{xb, (const bf16_t*)(ws + WS_WAIN + l * SZ_WAIN), S, NAIN, DM, LDX, LDX};
        EpiAIn e{(bf16_t*)(ws + WS_U), (bf16_t*)(ws + WS_V), rowsq + (size_t)L * S * 8, (float*)(ws + WS_VSQ) + (size_t)l * S * 16, dry, (LAS float*)(lds + LDS_XBUF)};
        so.init(S, NAIN, gridDim.x, blockIdx.x);
        pg8::gemm_phase(lds, g, so, e, tid);
    } else if constexpr (KIND == 1) {
        mix_phase(p, l, (char*)smem, tid);
    } else if constexpr (KIND == 2) {
        const int L = 2 * l;
        pg8::Gemm g{(const bf16_t*)(ws + WS_Y), (const bf16_t*)(ws + WS_WAOUT + l * SZ_WAOUT), S, DM, AW, LDA4, LDA4};
        so.init(S, DM, gridDim.x, blockIdx.x);
        {
            EpiOutDrain e{l == 0 ? p.x : nullptr, xb, dry ? (float*)(ws + WS_U) : p.out, dry ? (bf16_t*)(ws + WS_V) : xb, rowsq + (size_t)(L + 1) * S * 8, 0, dry};
            pg8::gemm_phase(lds, g, so, e, tid);
        }
    } else if constexpr (KIND == 3) {
        const int L = 2 * l + 1;
        flog_phase(p, l, lds, tid);
        pg8::Gemm g{xb, (const bf16_t*)(ws + WS_WBIN + l * SZ_WBIN), S, NBIN, DM, LDX, LDX};
        EpiBIn e{(bf16_t*)(ws + WS_U), (bf16_t*)(ws + WS_V), (bf16_t*)(ws + WS_Z), rowsq + (size_t)L * S * 8,
                 p.b_q_norm_g + l * HD, p.b_k_norm_g + l * HD, (LAS float*)(lds + LDS_XBUF)};
        so.init(S, NBIN, gridDim.x, blockIdx.x);
        pg8::gemm_phase(lds, g, so, e, tid);
    } else if constexpr (KIND == 4) {
        attn_phase(p, l, (char*)smem);
    } else {
        const int L = 2 * l + 1;
        pg8::Gemm g{(const bf16_t*)(ws + WS_Y), (const bf16_t*)(ws + WS_WBOUT + l * SZ_WBOUT), S, DM, DM, LDX, LDX};
        so.init(S, DM, gridDim.x, blockIdx.x);
        {
            EpiOutDrain e{nullptr, xb, dry ? (float*)(ws + WS_U) : p.out, dry ? (bf16_t*)(ws + WS_V) : xb, rowsq + (size_t)(l == 1 ? 0 : (L + 1)) * S * 8, l == 1 ? 1 : 0, dry};
            pg8::gemm_phase(lds, g, so, e, tid);
        }
    }
}

__global__ void __launch_bounds__(512, 2) k_mega(Params p) {
    extern __shared__ __attribute__((aligned(16))) unsigned char smem[];
    cg::grid_group grid = cg::this_grid();
#ifndef PROBE_DUP
#define PROBE_DUP 0
#endif
#define GSYNC() do { if (PROBE_DUP & 256) grid.sync(); else grid_bar(bar, epoch); } while (0)
#define RUNPH(ph, body) do { const int ph_ = (ph); if (p.ph_lo <= ph_ && ph_ < p.ph_hi) { body; if (ph_ + 1 < p.ph_hi) { GSYNC(); if (PROBE_DUP & 128) GSYNC(); } } } while (0)
#define DUP(bit, body) do { if (PROBE_DUP & (1 << (bit))) { body; GSYNC(); } } while (0)
    unsigned* bar = (unsigned*)(p.ws + WS_BAR); unsigned epoch = 0;
    if (p.ph_lo <= 0 && 0 < p.ph_hi) {
        phase0(p, (LAS unsigned char*)smem);
        if (1 < p.ph_hi) GSYNC();
        if (p.ph_hi > NPHASES) grid.sync();
    }
    DUP(0, phase0(p, (LAS unsigned char*)smem));
    for (int l = 0; l < 2; ++l) {
        DUP(1, run_layer_phase<0>(p, l, smem, 1));
        RUNPH(1 + 6 * l, run_layer_phase<0>(p, l, smem));
        DUP(2, run_layer_phase<1>(p, l, smem, 1));
        RUNPH(2 + 6 * l, run_layer_phase<1>(p, l, smem));
        DUP(3, run_layer_phase<2>(p, l, smem, 1));
        RUNPH(3 + 6 * l, run_layer_phase<2>(p, l, smem));
        DUP(4, run_layer_phase<3>(p, l, smem, 1));
        RUNPH(4 + 6 * l, run_layer_phase<3>(p, l, smem));
        DUP(5, run_layer_phase<4>(p, l, smem, 1));
        RUNPH(5 + 6 * l, run_layer_phase<4>(p, l, smem));
        DUP(6, run_layer_phase<5>(p, l, smem, 1));
        RUNPH(6 + 6 * l, run_layer_phase<5>(p, l, smem));
    }
#undef DUP
#undef GSYNC
#undef RUNPH
}

extern "C" void kernel_launch(void* const* d_in, const int* in_sizes, int n_in, void* d_out, int out_size, void* d_ws, size_t ws_size, hipStream_t stream) {
    static int grid = 0;
    if (grid == 0) {
        if (n_in != 13 || in_sizes[0] != S * DM || out_size != S * DM || ws_size < WS_END) {
            fprintf(stderr, "kernel_launch: unexpected shapes (n_in %d, in0 %d, out %d, ws %zu, need %zu)\n", n_in, n_in > 0 ? in_sizes[0] : -1, out_size, ws_size, (size_t)WS_END); grid = -1; return; }
        int dev = 0, cus = 0, per_cu = 0;
        (void)hipGetDevice(&dev); (void)hipDeviceGetAttribute(&cus, hipDeviceAttributeMultiprocessorCount, dev);
        if (hipFuncSetAttribute((const void*)k_mega, hipFuncAttributeMaxDynamicSharedMemorySize, LDS_BYTES) != hipSuccess) { fprintf(stderr, "kernel_launch: hipFuncSetAttribute failed\n"); grid = -1; return; }
        if (hipOccupancyMaxActiveBlocksPerMultiprocessor(&per_cu, (const void*)k_mega, 512, LDS_BYTES) != hipSuccess || per_cu < 1) { fprintf(stderr, "kernel_launch: occupancy query failed (%d)\n", per_cu); per_cu = 1; }
        (void)hipGetLastError();
        grid = cus * per_cu;
        if (grid != 256) { fprintf(stderr, "kernel_launch: this kernel needs exactly 256 resident workgroups (got %d x %d)\n", cus, per_cu); grid = 256; }
    }
    if (grid < 0) return;
    Params p{};
    p.x = (const float*)d_in[0]; p.a_norm_g = (const float*)d_in[1]; p.a_w_in = (const float*)d_in[2]; p.a_v_norm_g = (const float*)d_in[3];
    p.a_w_s = (const float*)d_in[4]; p.a_b_s = (const float*)d_in[5]; p.a_w_out = (const float*)d_in[6];
    p.b_norm_g = (const float*)d_in[7]; p.b_w_in = (const float*)d_in[8]; p.b_f_bias = (const float*)d_in[9];
    p.b_q_norm_g = (const float*)d_in[10]; p.b_k_norm_g = (const float*)d_in[11]; p.b_w_out = (const float*)d_in[12];
    p.out = (float*)d_out; p.ws = (unsigned char*)d_ws;
#if MK_MULTI
    for (int ph = 0; ph < NPHASES; ++ph) {
        p.ph_lo = ph; p.ph_hi = ph + 1;
        hipLaunchKernelGGL(k_mega, dim3(grid), dim3(512), LDS_BYTES, stream, p);
    }
#else
    p.ph_lo = 0; p.ph_hi = NPHASES;
    (void)hipMemsetAsync((unsigned char*)d_ws + WS_BAR, 0, 256, stream);
    void* args[] = {&p};
    hipError_t e = hipLaunchCooperativeKernel((const void*)k_mega, dim3(grid), dim3(512), args, LDS_BYTES, stream);
    if (e != hipSuccess) fprintf(stderr, "kernel_launch: cooperative launch failed: %s (grid %d)\n", hipGetErrorString(e), grid);
#endif
}
```

```cpp
#include <hip/hip_runtime.h>
#include <hip/hip_cooperative_groups.h>
#include <cstdio>
#include <cstdint>
namespace cg = cooperative_groups;

#ifndef MK_MULTI
#define MK_MULTI 0
#endif

#define LAS __attribute__((address_space(3)))
typedef unsigned short bf16_t;
typedef short bf16x8 __attribute__((ext_vector_type(8)));
typedef short s16x4 __attribute__((ext_vector_type(4)));
typedef float f32x2 __attribute__((ext_vector_type(2)));
typedef float f32x4 __attribute__((ext_vector_type(4)));
typedef float f32x16 __attribute__((ext_vector_type(16)));
typedef unsigned u32x2 __attribute__((ext_vector_type(2)));
typedef unsigned u32x4 __attribute__((ext_vector_type(4)));

constexpr int S = 8192, DM = 2048, AW = 4096, NAIN = 3 * AW, NBIN = 4 * DM, NBIN_LD = 4 * DM + 16, NH = 16, HD = 128, CH = 128, NG = 16, GD = 256;
constexpr int PADK = 64;
constexpr int LDX = DM + PADK, LDA4 = AW + PADK;
constexpr float EPS = 1e-6f;
constexpr float LOG2E = 1.4426950408889634f;
constexpr float QSCALE = 0.08838834764831845f * 1.4426950408889634f;

constexpr size_t SZ_WAIN = (size_t)NAIN * LDX * 2, SZ_WAOUT = (size_t)DM * LDA4 * 2, SZ_WBIN = (size_t)NBIN * LDX * 2, SZ_WBF = (size_t)32 * DM * 2, SZ_WBOUT = (size_t)DM * LDX * 2;
constexpr size_t WS_WAIN = 0;
constexpr size_t WS_WAOUT = WS_WAIN + 2 * SZ_WAIN;
constexpr size_t WS_WBIN = WS_WAOUT + 2 * SZ_WAOUT;
constexpr size_t WS_WBF = WS_WBIN + 2 * SZ_WBIN;
constexpr size_t WS_WBOUT = WS_WBF + 2 * SZ_WBF;
constexpr size_t WS_XB = WS_WBOUT + 2 * SZ_WBOUT;
constexpr size_t WS_U = WS_XB + (size_t)S * LDX * 2;
constexpr size_t WS_V = WS_U + (size_t)S * LDA4 * 2;
constexpr size_t WS_Z = WS_V + (size_t)S * LDA4 * 2;
constexpr size_t WS_Y = WS_Z + (size_t)S * LDA4 * 2;
constexpr size_t WS_ROWSQ = WS_Y + (size_t)S * LDA4 * 2;
constexpr size_t WS_VSQ = WS_ROWSQ + (size_t)4 * S * 8 * 4;
constexpr size_t WS_FLOG = WS_VSQ + (size_t)2 * S * 16 * 4;
constexpr size_t WS_WSB = WS_FLOG + (size_t)NH * S * 4;
constexpr size_t WS_BAR = WS_WSB + (size_t)2 * NG * CH * CH * 2;
constexpr size_t WS_END = WS_BAR + 256;

struct Params {
    const float* x; const float* a_norm_g; const float* a_w_in; const float* a_v_norm_g; const float* a_w_s; const float* a_b_s; const float* a_w_out;
    const float* b_norm_g; const float* b_w_in; const float* b_f_bias; const float* b_q_norm_g; const float* b_k_norm_g; const float* b_w_out;
    float* out; unsigned char* ws; int ph_lo, ph_hi;
};

__device__ __forceinline__ unsigned cvtpk(float lo, float hi) { unsigned r; asm volatile("v_cvt_pk_bf16_f32 %0, %1, %2" : "=v"(r) : "v"(lo), "v"(hi)); return r; }
__device__ __forceinline__ float bf2f(unsigned short b) { return __uint_as_float(((unsigned)b) << 16); }
__device__ __forceinline__ float wave_sum(float v) {
#pragma unroll
    for (int o = 32; o; o >>= 1) v += __shfl_xor(v, o);
    return v;
}
__device__ __forceinline__ float gelu_tanh(float x) {
    const float t = x * (1.f + 0.044715f * x * x);
    const float e = __builtin_amdgcn_exp2f(-2.3022082f * t);
    return x * __builtin_amdgcn_rcpf(1.f + e);
}
__device__ __forceinline__ float gate_uz(float u, float z) {
    const float t = u * (1.f + 0.044715f * u * u);
    const float eu = __builtin_amdgcn_exp2f(-2.3022082f * t), ez = __builtin_amdgcn_exp2f(-LOG2E * z);
    return (u * z) * __builtin_amdgcn_rcpf((1.f + eu) * (1.f + ez));
}
__device__ __forceinline__ float silu(float x) { return x * __builtin_amdgcn_rcpf(1.f + __builtin_amdgcn_exp2f(-LOG2E * x)); }
__device__ __forceinline__ bf16x8 pack8(f32x4 a, f32x4 b) {
    u32x4 w = {cvtpk(a[0], a[1]), cvtpk(a[2], a[3]), cvtpk(b[0], b[1]), cvtpk(b[2], b[3])};
    return *reinterpret_cast<bf16x8*>(&w);
}

namespace pg8 {
constexpr int BM = 256, BK = 64, HALF = 128, HTB = HALF * BK * 2, STAGE_BYTES = 8 * HTB, NXCD = 8, WGM = 8;
__host__ __device__ __forceinline__ int lds_byte(int r, int c) { const int st = (r >> 4) * 2 + (c >> 5), rr = r & 15, cc = c & 31, ob = rr * 64 + cc * 2; return st * 1024 + (ob ^ (((ob >> 9) & 1) << 5)); }
__host__ __device__ __forceinline__ void stage_rc(int b, int& R, int& C) { const int st = b / 1024, sb = b % 1024, swz = sb ^ (((sb >> 9) & 1) << 5); R = (st >> 1) * 16 + swz / 64; C = (st & 1) * 32 + (swz % 64) / 2; }
__host__ __device__ __forceinline__ int perm32(int rho) { const int n = rho >> 4, i = rho & 15; return 8 * (i >> 2) + 4 * n + (i & 3); }
struct Unit { int pm, pn; };
struct Gemm { const bf16_t* A; const bf16_t* Bt; int M, N, K, lda, ldb; };
struct StaticOrder {
    int nM, nN, nwg, G, c;
    __device__ void init(int M, int N, int G_, int c_) { nM = M / BM; nN = N / BM; nwg = nM * nN; G = G_; c = c_; }
    __device__ bool next(int i, Unit& u) const {
        const long L = (long)i * G + c; if (L >= nwg) return false;
        int wgid = (int)L; { const int q = nwg / NXCD, r = nwg % NXCD, xcd = wgid % NXCD, off = wgid / NXCD; wgid = (xcd < r ? xcd * (q + 1) : r * (q + 1) + (xcd - r) * q) + off; }
        const int nig = WGM * nN, gid = wgid / nig, fm = gid * WGM, gsz = (nM - fm) < WGM ? (nM - fm) : WGM;
        u.pm = fm + ((wgid % nig) % gsz); u.pn = (wgid % nig) / gsz; return true;
    }
};
#ifndef PG8_SP2
#define PG8_SP2 true
#endif
#ifndef PG8_ALIGN
#define PG8_ALIGN true
#endif
template <class Epi, bool ALIGN_EPI = PG8_ALIGN, bool SP2 = PG8_SP2>
__device__ __forceinline__ void gemm_phase(LAS unsigned char* lds, const Gemm g, const StaticOrder& S_, const Epi& E, const int tid) {
    const int wid = __builtin_amdgcn_readfirstlane(tid >> 6), lane = tid & 63, wr = wid >> 2, wc = wid & 3, fr = lane & 15, fq = lane >> 4;
    const int K = g.K, nt = K / BK;
    unsigned voffA[2], voffB[2];
#pragma unroll
    for (int i = 0; i < 2; ++i) { int R, C; stage_rc(tid * 16 + i * 8192, R, C); const int Rb = Epi::PERM ? ((R & ~31) + perm32(R & 31)) : R;
        voffA[i] = (unsigned)(R * g.lda + C) * 2u; voffB[i] = (unsigned)(Rb * g.ldb + C) * 2u; }
    const size_t kstep = (size_t)(BK * 2);
    const size_t hstepA = (size_t)HALF * g.lda * 2, hstepB = (size_t)HALF * g.ldb * 2;
    const size_t tstepA = 2 * hstepA, tstepB = 2 * hstepB;
    const unsigned ldsw = (unsigned)wid * 1024u;
    const int aoff = lds_byte(wr * 64 + fr, fq * 8), boff = lds_byte(wc * 32 + fr, fq * 8);
#define PG8_SA(b, h) (((b) * 2 + (h)) * HTB)
#define PG8_SB(b, h) ((4 + (b) * 2 + (h)) * HTB)
#define PG8_STAGE(bufoff, gbase, voff) do { _Pragma("unroll") for (int _i = 0; _i < 2; ++_i) \
        __builtin_amdgcn_global_load_lds((const unsigned*)((const char*)(gbase) + (voff)[_i]), (LAS unsigned*)(lds + (bufoff) + ldsw + _i * 8192), 16, 0, 0); } while (0)
#define PG8_LDA(dst, b, h) do { _Pragma("unroll") for (int m = 0; m < 4; ++m) _Pragma("unroll") for (int k = 0; k < 2; ++k) dst[m][k] = *(const LAS bf16x8*)(lds + PG8_SA(b, h) + aoff + m * 2048 + k * 1024); } while (0)
#define PG8_LDB(dst, b, h) do { _Pragma("unroll") for (int n = 0; n < 2; ++n) _Pragma("unroll") for (int k = 0; k < 2; ++k) dst[n][k] = *(const LAS bf16x8*)(lds + PG8_SB(b, h) + boff + n * 2048 + k * 1024); } while (0)
#define PG8_MMA(ai, bj, At, Bt) do { __builtin_amdgcn_s_setprio(1); _Pragma("unroll") for (int m = 0; m < 4; ++m) _Pragma("unroll") for (int n = 0; n < 2; ++n) _Pragma("unroll") for (int k = 0; k < 2; ++k) \
        acc[ai][bj][m][n] = __builtin_amdgcn_mfma_f32_16x16x32_bf16(Bt[n][k], At[m][k], acc[ai][bj][m][n], 0, 0, 0); __builtin_amdgcn_s_setprio(0); } while (0)
#define PG8_WAIT_V(n) asm volatile("s_waitcnt vmcnt(" #n ")" ::: "memory")
#define PG8_WAIT_L(n) asm volatile("s_waitcnt lgkmcnt(" #n ")" ::: "memory")
#define PG8_BAR __builtin_amdgcn_s_barrier()
#define PG8_SCHED __builtin_amdgcn_sched_barrier(0)
    Unit cur, nxt; int ui = 0;
    if (!S_.next(0, cur)) return;
    f32x4 acc[2][2][4][2];
#pragma unroll
    for (int a = 0; a < 2; ++a)
#pragma unroll
        for (int b = 0; b < 2; ++b)
#pragma unroll
            for (int m = 0; m < 4; ++m)
#pragma unroll
                for (int n = 0; n < 2; ++n) acc[a][b][m][n] = (f32x4){0.f, 0.f, 0.f, 0.f};
    bf16x8 At[4][2], B0[2][2], B1[2][2];
    const char* cA = (const char*)g.A + (size_t)cur.pm * tstepA; const char* cB = (const char*)g.Bt + (size_t)cur.pn * tstepB;
    if constexpr (SP2) {
        PG8_STAGE(PG8_SB(0, 0), cB, voffB); PG8_STAGE(PG8_SB(0, 1), cB + hstepB, voffB); PG8_STAGE(PG8_SA(0, 0), cA, voffA); PG8_STAGE(PG8_SA(0, 1), cA + hstepA, voffA);
        if (wr == 1) PG8_BAR;
        PG8_WAIT_V(2); PG8_BAR;
        PG8_STAGE(PG8_SB(1, 0), cB + kstep, voffB); PG8_STAGE(PG8_SA(1, 0), cA + kstep, voffA); PG8_STAGE(PG8_SB(1, 1), cB + hstepB + kstep, voffB);
        PG8_WAIT_V(6); PG8_BAR;
    } else {
        PG8_STAGE(PG8_SB(0, 0), cB, voffB); PG8_STAGE(PG8_SA(0, 0), cA, voffA); PG8_STAGE(PG8_SB(0, 1), cB + hstepB, voffB); PG8_STAGE(PG8_SA(0, 1), cA + hstepA, voffA);
        if (wr == 1) PG8_BAR;
        PG8_WAIT_V(4); PG8_BAR;
        PG8_STAGE(PG8_SB(1, 0), cB + kstep, voffB); PG8_STAGE(PG8_SA(1, 0), cA + kstep, voffA); PG8_STAGE(PG8_SB(1, 1), cB + hstepB + kstep, voffB);
        PG8_WAIT_V(6); PG8_BAR;
    }
    for (;;) {
        const bool has_next = S_.next(ui + 1, nxt);
        const char* nA = has_next ? (const char*)g.A + (size_t)nxt.pm * tstepA : cA; const char* nB = has_next ? (const char*)g.Bt + (size_t)nxt.pn * tstepB : cB;
        for (int t = 0; t < nt; t += 2) {
            const bool last = (t == nt - 2);
            const char* a1 = cA + (size_t)(t + 1) * kstep;
            const char* a2 = last ? nA : cA + (size_t)(t + 2) * kstep; const char* b2 = last ? nB : cB + (size_t)(t + 2) * kstep;
            const char* a3 = a2 + kstep; const char* b3 = b2 + kstep;
            if constexpr (SP2) {
            PG8_LDB(B0, 0, 0); PG8_LDB(B1, 0, 1); PG8_SCHED; PG8_LDA(At, 0, 0); PG8_STAGE(PG8_SA(1, 1), a1 + hstepA, voffA);
            PG8_WAIT_V(8); PG8_WAIT_L(0); PG8_BAR; PG8_MMA(0, 0, At, B0); PG8_MMA(0, 1, At, B1); PG8_BAR; PG8_SCHED;
            PG8_LDA(At, 0, 1); PG8_STAGE(PG8_SB(0, 0), b2, voffB); PG8_STAGE(PG8_SB(0, 1), b2 + hstepB, voffB); PG8_STAGE(PG8_SA(0, 0), a2, voffA);
            PG8_WAIT_V(8); PG8_WAIT_L(0); PG8_BAR; PG8_MMA(1, 0, At, B0); PG8_MMA(1, 1, At, B1); PG8_BAR; PG8_SCHED;
            PG8_LDB(B0, 1, 0); PG8_LDB(B1, 1, 1); PG8_SCHED; PG8_LDA(At, 1, 0); PG8_STAGE(PG8_SA(0, 1), a2 + hstepA, voffA);
            PG8_WAIT_V(8); PG8_WAIT_L(0); PG8_BAR; PG8_MMA(0, 0, At, B0); PG8_MMA(0, 1, At, B1); PG8_BAR; PG8_SCHED;
            PG8_LDA(At, 1, 1); PG8_STAGE(PG8_SB(1, 0), b3, voffB); PG8_STAGE(PG8_SB(1, 1), b3 + hstepB, voffB); PG8_STAGE(PG8_SA(1, 0), a3, voffA);
            PG8_WAIT_V(8); PG8_WAIT_L(0); PG8_BAR; PG8_MMA(1, 0, At, B0); PG8_MMA(1, 1, At, B1); PG8_BAR; PG8_SCHED;
            } else {
            PG8_LDB(B0, 0, 0); PG8_SCHED; PG8_LDA(At, 0, 0); PG8_STAGE(PG8_SA(1, 1), a1 + hstepA, voffA);
            PG8_WAIT_L(8); PG8_BAR; PG8_WAIT_L(0); PG8_MMA(0, 0, At, B0); PG8_BAR; PG8_SCHED;
            PG8_LDB(B1, 0, 1); PG8_STAGE(PG8_SB(0, 0), b2, voffB);
            PG8_BAR; PG8_WAIT_L(0); PG8_MMA(0, 1, At, B1); PG8_BAR;
            PG8_LDA(At, 0, 1); PG8_STAGE(PG8_SA(0, 0), a2, voffA);
            PG8_BAR; PG8_WAIT_L(0); PG8_MMA(1, 0, At, B0); PG8_BAR; PG8_SCHED;
            PG8_STAGE(PG8_SB(0, 1), b2 + hstepB, voffB);
            PG8_WAIT_V(6); PG8_BAR; PG8_MMA(1, 1, At, B1); PG8_BAR;
            PG8_LDB(B0, 1, 0); PG8_SCHED; PG8_LDA(At, 1, 0); PG8_STAGE(PG8_SA(0, 1), a2 + hstepA, voffA);
            PG8_WAIT_L(8); PG8_BAR; PG8_WAIT_L(0); PG8_MMA(0, 0, At, B0); PG8_BAR; PG8_SCHED;
            PG8_LDB(B1, 1, 1); PG8_STAGE(PG8_SB(1, 0), b3, voffB);
            PG8_BAR; PG8_WAIT_L(0); PG8_MMA(0, 1, At, B1); PG8_BAR;
            PG8_LDA(At, 1, 1); PG8_STAGE(PG8_SA(1, 0), a3, voffA);
            PG8_BAR; PG8_WAIT_L(0); PG8_MMA(1, 0, At, B0); PG8_BAR; PG8_SCHED;
            PG8_STAGE(PG8_SB(1, 1), b3 + hstepB, voffB);
            PG8_WAIT_V(6); PG8_BAR; PG8_MMA(1, 1, At, B1); PG8_BAR;
            }
        }
        if constexpr (ALIGN_EPI) { if (wr == 0) PG8_BAR; }
        if constexpr (!Epi::AFTER_DRAIN) E(acc, cur, wr, wc, fr, fq);
        if (!has_next) break;
#pragma unroll
        for (int a = 0; a < 2; ++a)
#pragma unroll
            for (int b = 0; b < 2; ++b)
#pragma unroll
                for (int m = 0; m < 4; ++m)
#pragma unroll
                    for (int n = 0; n < 2; ++n) acc[a][b][m][n] = (f32x4){0.f, 0.f, 0.f, 0.f};
        cur = nxt; cA = nA; cB = nB; ++ui;
        if constexpr (ALIGN_EPI) { if (wr == 1) PG8_BAR; }
    }
    PG8_WAIT_V(0);
    if constexpr (!ALIGN_EPI) { if (wr == 0) PG8_BAR; }
    PG8_BAR;
    if constexpr (Epi::AFTER_DRAIN) E.fused(acc, cur, wr, wc, fr, fq, lds, wid, lane);
#undef PG8_SA
#undef PG8_SB
#undef PG8_STAGE
#undef PG8_LDA
#undef PG8_LDB
#undef PG8_MMA
#undef PG8_WAIT_V
#undef PG8_WAIT_L
#undef PG8_BAR
#undef PG8_SCHED
}
}
using pg8::Unit;
typedef f32x4 AccT[2][2][4][2];

__device__ __forceinline__ float row_rstd8(const float* part) {
    const f32x4 a = *(const f32x4*)part, b = *(const f32x4*)(part + 4);
    return __builtin_amdgcn_rsqf((((a[0] + a[1]) + (a[2] + a[3])) + ((b[0] + b[1]) + (b[2] + b[3]))) * (1.f / DM) + EPS);
}
struct EpiAIn {
    static constexpr bool PERM = true, AFTER_DRAIN = false;
    bf16_t* G; bf16_t* V; const float* rowsq; float* vsq; int dry; LAS float* xbuf;
    __device__ __forceinline__ void operator()(const AccT& acc, const Unit& u, int wr, int wc, int fr, int fq) const {
        const bool isv = u.pn >= 32;
        int c8 = wc * 32 + 8 * fq; asm volatile("" : "+v"(c8));
        const int row0 = u.pm * 256 + wr * 64 + fr;
        float rstd[2][4];
#pragma unroll
        for (int ai = 0; ai < 2; ++ai)
#pragma unroll
            for (int m = 0; m < 4; ++m) rstd[ai][m] = row_rstd8(rowsq + (size_t)(row0 + ai * 128 + m * 16) * 8);
        if (!isv) {
            const int col0 = u.pn * 128 + c8;
#pragma unroll
            for (int ai = 0; ai < 2; ++ai)
#pragma unroll
                for (int m = 0; m < 4; ++m) {
                    const int row = row0 + ai * 128 + m * 16;
                    f32x4 u0 = acc[ai][0][m][0] * rstd[ai][m], u1 = acc[ai][0][m][1] * rstd[ai][m], z0 = acc[ai][1][m][0] * rstd[ai][m], z1 = acc[ai][1][m][1] * rstd[ai][m];
#pragma unroll
                    for (int e = 0; e < 4; ++e) { u0[e] = gate_uz(u0[e], z0[e]); u1[e] = gate_uz(u1[e], z1[e]); }
                    *(bf16x8*)(G + (size_t)row * LDA4 + col0) = pack8(u0, u1);
                }
        } else {
            const int col0 = (u.pn - 32) * 256 + c8;
#pragma unroll
            for (int ai = 0; ai < 2; ++ai)
#pragma unroll
                for (int m = 0; m < 4; ++m) {
                    const int row = row0 + ai * 128 + m * 16;
                    float ss = 0.f;
#pragma unroll
                    for (int bj = 0; bj < 2; ++bj) {
                        f32x4 v0 = acc[ai][bj][m][0] * rstd[ai][m], v1 = acc[ai][bj][m][1] * rstd[ai][m];
#pragma unroll
                        for (int e = 0; e < 4; ++e) { v0[e] = gelu_tanh(v0[e]); v1[e] = gelu_tanh(v1[e]); ss += v0[e] * v0[e] + v1[e] * v1[e]; }
                        *(bf16x8*)(V + (size_t)row * LDA4 + col0 + bj * 128) = pack8(v0, v1);
                    }
                    ss += __shfl_xor(ss, 16); ss += __shfl_xor(ss, 32); if (fq == 0) xbuf[(ai * 128 + wr * 64 + m * 16 + fr) * 4 + wc] = ss;
                }
            asm volatile("s_waitcnt lgkmcnt(0)" ::: "memory"); __builtin_amdgcn_s_barrier(); asm volatile("" ::: "memory");
            if (wc == 0 && fq == 0 && !dry) {
#pragma unroll
                for (int ai = 0; ai < 2; ++ai)
#pragma unroll
                    for (int m = 0; m < 4; ++m) { const int rl = ai * 128 + wr * 64 + m * 16 + fr; const f32x4 q = *(const LAS f32x4*)(xbuf + rl * 4);
                        vsq[(size_t)(u.pm * 256 + rl) * 16 + (u.pn - 32)] = (q[0] + q[1]) + (q[2] + q[3]); }
            }
        }
    }
};
struct EpiOutDrain {
    static constexpr bool PERM = false, AFTER_DRAIN = true;
    const float* resid; const bf16_t* xb_in; float* out; bf16_t* xb; float* rowsq_next; int last; int dry;
    __device__ __forceinline__ void fused(const AccT& acc, const Unit& u, int wr, int wc, int fr, int fq, LAS unsigned char* lds, int wid, int lane) const {
        constexpr int SLD = 260;
        LAS float* slab = (LAS float*)lds;
        int c4 = 4 * lane; asm volatile("" : "+v"(c4));
#pragma unroll
        for (int ai = 0; ai < 2; ++ai) {
#pragma unroll
            for (int m = 0; m < 4; ++m)
#pragma unroll
                for (int bj = 0; bj < 2; ++bj)
#pragma unroll
                    for (int n = 0; n < 2; ++n) *(LAS f32x4*)(slab + (wr * 64 + m * 16 + fr) * SLD + bj * 128 + wc * 32 + n * 16 + 4 * fq) = acc[ai][bj][m][n];
            const int grow0 = u.pm * 256 + ai * 128 + wid * 16, gcol = u.pn * 256 + c4;
            f32x4 rr[16];
            if (resid) {
#pragma unroll
                for (int i = 0; i < 16; ++i) rr[i] = *(const f32x4*)(resid + (size_t)(grow0 + i) * DM + gcol);
            } else {
#pragma unroll
                for (int i = 0; i < 16; ++i) { const u32x2 w = *(const u32x2*)(xb_in + (size_t)(grow0 + i) * LDX + gcol);
                    rr[i] = (f32x4){__uint_as_float(w[0] << 16), __uint_as_float(w[0] & 0xffff0000u), __uint_as_float(w[1] << 16), __uint_as_float(w[1] & 0xffff0000u)}; }
            }
            asm volatile("s_waitcnt lgkmcnt(0)" ::: "memory"); __builtin_amdgcn_s_barrier(); asm volatile("" ::: "memory");
            float sq[16];
#pragma unroll
            for (int i = 0; i < 16; ++i) {
                const f32x4 a = *(const LAS f32x4*)(slab + (wid * 16 + i) * SLD + c4);
                const f32x4 v = rr[i] + a;
                if (last) *(f32x4*)(out + (size_t)(grow0 + i) * DM + gcol) = v;
                else { u32x2 w = {cvtpk(v[0], v[1]), cvtpk(v[2], v[3])}; *(u32x2*)(xb + (size_t)(grow0 + i) * LDX + gcol) = w; }
                sq[i] = v[0] * v[0] + v[1] * v[1] + v[2] * v[2] + v[3] * v[3];
            }
            if (!last) {
                const bool b5 = lane & 32, b4 = lane & 16, b3 = lane & 8, b2 = lane & 4;
                float t8[8], t4[4], t2[2];
#pragma unroll
                for (int i = 0; i < 8; ++i) { const float mine = b5 ? sq[8 + i] : sq[i], send = b5 ? sq[i] : sq[8 + i]; t8[i] = mine + __shfl_xor(send, 32); }
#pragma unroll
                for (int i = 0; i < 4; ++i) { const float mine = b4 ? t8[4 + i] : t8[i], send = b4 ? t8[i] : t8[4 + i]; t4[i] = mine + __shfl_xor(send, 16); }
#pragma unroll
                for (int i = 0; i < 2; ++i) { const float mine = b3 ? t4[2 + i] : t4[i], send = b3 ? t4[i] : t4[2 + i]; t2[i] = mine + __shfl_xor(send, 8); }
                float x1 = (b2 ? t2[1] : t2[0]) + __shfl_xor(b2 ? t2[0] : t2[1], 4);
                x1 += __shfl_xor(x1, 2); x1 += __shfl_xor(x1, 1);
                if ((lane & 3) == 0 && !dry) rowsq_next[(size_t)(grow0 + ((lane >> 2) & 15)) * 8 + u.pn] = x1;
            }
            asm volatile("s_waitcnt lgkmcnt(0)" ::: "memory"); __builtin_amdgcn_s_barrier(); asm volatile("" ::: "memory");
        }
    }
};
struct EpiBIn {
    static constexpr bool PERM = true, AFTER_DRAIN = false;
    bf16_t* Q; bf16_t* V; bf16_t* Z; const float* rowsq; const float* gq; const float* gk; LAS float* xbuf;
    __device__ __forceinline__ void operator()(const AccT& acc, const Unit& u, int wr, int wc, int fr, int fq) const {
        const int sec = u.pn >> 3, hp = u.pn & 7;
        int d0 = wc * 32 + 8 * fq; asm volatile("" : "+v"(d0));
        const int row0 = u.pm * 256 + wr * 64 + fr;
        float rstd[2][4];
#pragma unroll
        for (int ai = 0; ai < 2; ++ai)
#pragma unroll
            for (int m = 0; m < 4; ++m) rstd[ai][m] = row_rstd8(rowsq + (size_t)(row0 + ai * 128 + m * 16) * 8);
        if (sec < 2) {
#pragma unroll
            for (int ai = 0; ai < 2; ++ai)
#pragma unroll
                for (int m = 0; m < 4; ++m)
#pragma unroll
                    for (int bj = 0; bj < 2; ++bj) {
                        const f32x4 v0 = acc[ai][bj][m][0] * rstd[ai][m], v1 = acc[ai][bj][m][1] * rstd[ai][m];
                        float ss = 0.f;
#pragma unroll
                        for (int e = 0; e < 4; ++e) ss += v0[e] * v0[e] + v1[e] * v1[e];
                        ss += __shfl_xor(ss, 16); ss += __shfl_xor(ss, 32);
                        if (fq == 0) xbuf[((ai * 128 + wr * 64 + m * 16 + fr) * 2 + bj) * 4 + wc] = ss;
                    }
            asm volatile("s_waitcnt lgkmcnt(0)" ::: "memory"); __builtin_amdgcn_s_barrier(); asm volatile("" ::: "memory");
            const float* gg = sec == 0 ? gq : gk;
            const f32x4 g0 = *(const f32x4*)(gg + d0), g1 = *(const f32x4*)(gg + d0 + 4);
            const float sc = sec == 0 ? QSCALE : 1.f;
            bf16_t* base = Q + (size_t)sec * ((size_t)NH * S * HD);
#pragma unroll
            for (int ai = 0; ai < 2; ++ai)
#pragma unroll
                for (int m = 0; m < 4; ++m)
#pragma unroll
                    for (int bj = 0; bj < 2; ++bj) {
                        const f32x4 p = *(const LAS f32x4*)(xbuf + ((ai * 128 + wr * 64 + m * 16 + fr) * 2 + bj) * 4);
                        const float rs = __builtin_amdgcn_rsqf((p[0] + p[1] + p[2] + p[3]) * (1.f / HD) + EPS) * rstd[ai][m] * sc;
                        const f32x4 v0 = acc[ai][bj][m][0] * rs * g0, v1 = acc[ai][bj][m][1] * rs * g1;
                        const int row = row0 + ai * 128 + m * 16, head = hp * 2 + bj;
                        *(bf16x8*)(base + ((size_t)head * S + row) * HD + d0) = pack8(v0, v1);
                    }
        } else if (sec == 2) {
#pragma unroll
            for (int ai = 0; ai < 2; ++ai)
#pragma unroll
                for (int m = 0; m < 4; ++m)
#pragma unroll
                    for (int bj = 0; bj < 2; ++bj) {
                        const int row = row0 + ai * 128 + m * 16, head = hp * 2 + bj;
                        *(bf16x8*)(V + ((size_t)head * S + row) * HD + d0) = pack8(acc[ai][bj][m][0] * rstd[ai][m], acc[ai][bj][m][1] * rstd[ai][m]);
                    }
        } else {
#pragma unroll
            for (int ai = 0; ai < 2; ++ai)
#pragma unroll
                for (int m = 0; m < 4; ++m)
#pragma unroll
                    for (int bj = 0; bj < 2; ++bj) {
                        f32x4 v0 = acc[ai][bj][m][0] * rstd[ai][m], v1 = acc[ai][bj][m][1] * rstd[ai][m];
#pragma unroll
                        for (int e = 0; e < 4; ++e) { v0[e] = silu(v0[e]); v1[e] = silu(v1[e]); }
                        const int row = row0 + ai * 128 + m * 16;
                        *(bf16x8*)(Z + (size_t)row * LDX + hp * 256 + bj * 128 + d0) = pack8(v0, v1);
                    }
        }
    }
};

__device__ __forceinline__ int uz_row(int n) { return n < AW ? ((n >> 7) * 256 + (n & 127)) : (n < 2 * AW ? (2 * AW + (n - AW)) : (((n - 2 * AW) >> 7) * 256 + 128 + ((n - 2 * AW) & 127))); }
__device__ __forceinline__ void conv_tiles(const float* __restrict__ src, int ld, int K, int ncols, bf16_t* __restrict__ dst, const float* __restrict__ g, LAS float* tile, bool uzmap = false) {
    const int ldd = K + PADK;
    const int tid = threadIdx.x, lk = tid >> 6, ln = tid & 63;
    const int nnt = ncols / 256, ntiles = (K / 64) * nnt;
    f32x4 v[8];
    int t = blockIdx.x;
#define CONV_ISSUE(tt) do { const int n0_ = ((tt) % nnt) * 256, k0_ = ((tt) / nnt) * 64; _Pragma("unroll") for (int i = 0; i < 8; ++i) \
        v[i] = __builtin_nontemporal_load((const f32x4*)(src + (size_t)(k0_ + lk + 8 * i) * ld + n0_ + ln * 4)); } while (0)
    if (t < ntiles) CONV_ISSUE(t);
    for (; t < ntiles; t += gridDim.x) {
        const int n0 = (t % nnt) * 256, k0 = (t / nnt) * 64;
#pragma unroll
        for (int i = 0; i < 8; ++i) { const int k = lk + 8 * i; const float sc = g ? g[k0 + k] : 1.f;
#pragma unroll
            for (int e = 0; e < 4; ++e) tile[k * 257 + e * 64 + ln] = v[i][e] * sc; }
        __syncthreads();
        if (t + (int)gridDim.x < ntiles) CONV_ISSUE(t + gridDim.x);
#pragma unroll
        for (int i = 0; i < 4; ++i) { const int r = tid + 512 * i, kg = r & 7, m = (r >> 3) & 63, e = r >> 9, n = 4 * m + e;
            f32x4 a, b;
#pragma unroll
            for (int j = 0; j < 4; ++j) { a[j] = tile[(kg * 8 + j) * 257 + e * 64 + m]; b[j] = tile[(kg * 8 + 4 + j) * 257 + e * 64 + m]; }
            *(bf16x8*)(dst + (size_t)(uzmap ? uz_row(n0 + n) : (n0 + n)) * ldd + k0 + kg * 8) = pack8(a, b); }
        __syncthreads();
    }
#undef CONV_ISSUE
}
__device__ __forceinline__ void phase0(const Params& p, LAS unsigned char* lds) {
    LAS float* tile = (LAS float*)lds;
    unsigned char* ws = p.ws;
    const int tid = threadIdx.x, wid = tid >> 6, lane = tid & 63;
    const int gtid = blockIdx.x * 512 + tid, gsz = gridDim.x * 512;
    { bf16_t* wsb = (bf16_t*)(ws + WS_WSB);
      for (int i = gtid; i < 2 * NG * CH * CH / 4; i += gsz) { const int e = i * 4, tt = (e >> 7) & 127, s0 = e & 127;
          const f32x4 v = *(const f32x4*)(p.a_w_s + e);
          u32x2 w = {cvtpk(s0 <= tt ? v[0] : 0.f, s0 + 1 <= tt ? v[1] : 0.f), cvtpk(s0 + 2 <= tt ? v[2] : 0.f, s0 + 3 <= tt ? v[3] : 0.f)};
          *(u32x2*)(wsb + e) = w; } }
    for (int l = 0; l < 2; ++l) { bf16_t* wf = (bf16_t*)(ws + WS_WBF + l * SZ_WBF);
        for (int i = gtid; i < 32 * DM; i += gsz) { const int j = i / DM, k = i % DM;
            const float v = j < 16 ? p.b_w_in[(size_t)l * DM * NBIN_LD + (size_t)k * NBIN_LD + NBIN + j] * p.b_norm_g[l * DM + k] : 0.f;
            wf[i] = (bf16_t)(cvtpk(v, 0.f) & 0xffffu); } }
    for (int l = 1; l >= 0; --l) {
        conv_tiles(p.b_w_out + (size_t)l * DM * DM, DM, DM, DM, (bf16_t*)(ws + WS_WBOUT + l * SZ_WBOUT), nullptr, tile);
        conv_tiles(p.b_w_in + (size_t)l * DM * NBIN_LD, NBIN_LD, DM, NBIN, (bf16_t*)(ws + WS_WBIN + l * SZ_WBIN), p.b_norm_g + l * DM, tile);
        conv_tiles(p.a_w_out + (size_t)l * AW * DM, DM, AW, DM, (bf16_t*)(ws + WS_WAOUT + l * SZ_WAOUT), nullptr, tile);
        conv_tiles(p.a_w_in + (size_t)l * DM * NAIN, NAIN, DM, NAIN, (bf16_t*)(ws + WS_WAIN + l * SZ_WAIN), p.a_norm_g + l * DM, tile, true);
    }
    { bf16_t* xb = (bf16_t*)(ws + WS_XB); float* rsq = (float*)(ws + WS_ROWSQ);
      for (int row = blockIdx.x * 8 + wid; row < S; row += gridDim.x * 8) {
          const float* xr = p.x + (size_t)row * DM; f32x4 v[8]; float ss = 0.f;
#pragma unroll
          for (int i = 0; i < 8; ++i) { v[i] = *(const f32x4*)(xr + i * 256 + lane * 4); ss += v[i][0] * v[i][0] + v[i][1] * v[i][1] + v[i][2] * v[i][2] + v[i][3] * v[i][3]; }
          ss = wave_sum(ss);
#pragma unroll
          for (int i = 0; i < 8; ++i) { u32x2 w = {cvtpk(v[i][0], v[i][1]), cvtpk(v[i][2], v[i][3])}; *(u32x2*)(xb + (size_t)row * LDX + i * 256 + lane * 4) = w; }
          if (lane < 8) rsq[(size_t)row * 8 + lane] = lane == 0 ? ss : 0.f;
      } }
}

constexpr int SHM_V = 64 * 128 * 2, SHM_K = 64 * 128 * 2;
__device__ __forceinline__ int v_st(int k, int c) { const int kk = (k & ~0xC) | ((k & 4) << 1) | ((k & 8) >> 1); return ((kk >> 3) * 4 + (c >> 5)) * 512 + ((kk & 7) * 32 + (c & 31)) * 2; }
__device__ __forceinline__ int v_rd_base(int lane) { return ((lane & 3) << 3) | (((lane >> 2) & 3) << 6) | (((lane >> 4) & 1) << 5) | (((lane >> 5) & 1) << 8); }
constexpr int v_rd_off(int d0, int ks, int half) { return d0 * 512 + ks * 4096 + half * 2048; }
__device__ __forceinline__ int crow(int r, int hi) { return (r & 3) + 8 * (r >> 2) + 4 * hi; }
#define SBAR() __builtin_amdgcn_sched_barrier(0)
template <int VOFF>
__device__ __forceinline__ void pv_tile(f32x16* o, int vb0, bf16x8 pa0, bf16x8 pa1, bf16x8 pa2, bf16x8 pa3) {
#define TRRD(dst, off) asm volatile("ds_read_b64_tr_b16 %0, %1 offset:%2" : "=&v"(dst) : "v"(vb0), "i"(off) : "memory")
#define PV_D0(d0) do { s16x4 l0, l1, l2, l3, h0, h1, h2, h3; constexpr int b_ = VOFF + v_rd_off(d0, 0, 0); \
        TRRD(l0, b_); TRRD(h0, b_ + 2048); TRRD(l1, b_ + 4096); TRRD(h1, b_ + 6144); TRRD(l2, b_ + 8192); TRRD(h2, b_ + 10240); TRRD(l3, b_ + 12288); TRRD(h3, b_ + 14336); \
        asm volatile("s_waitcnt lgkmcnt(0)" ::: "memory"); SBAR(); \
        o[d0] = __builtin_amdgcn_mfma_f32_32x32x16_bf16((bf16x8){l0[0], l0[1], l0[2], l0[3], h0[0], h0[1], h0[2], h0[3]}, pa0, o[d0], 0, 0, 0);   \
        o[d0] = __builtin_amdgcn_mfma_f32_32x32x16_bf16((bf16x8){l1[0], l1[1], l1[2], l1[3], h1[0], h1[1], h1[2], h1[3]}, pa1, o[d0], 0, 0, 0);   \
        o[d0] = __builtin_amdgcn_mfma_f32_32x32x16_bf16((bf16x8){l2[0], l2[1], l2[2], l2[3], h2[0], h2[1], h2[2], h2[3]}, pa2, o[d0], 0, 0, 0);   \
        o[d0] = __builtin_amdgcn_mfma_f32_32x32x16_bf16((bf16x8){l3[0], l3[1], l3[2], l3[3], h3[0], h3[1], h3[2], h3[3]}, pa3, o[d0], 0, 0, 0); } while (0)
    PV_D0(0); PV_D0(1); PV_D0(2); PV_D0(3);
#undef PV_D0
#undef TRRD
}

__device__ __forceinline__ void mix_phase(const Params& p, int l, char* lds, const int tid) {
    unsigned char* ws = p.ws;
    const bf16_t* U = (const bf16_t*)(ws + WS_U); const bf16_t* Vb = (const bf16_t*)(ws + WS_V); bf16_t* Y = (bf16_t*)(ws + WS_Y);
    const float* vsq = (const float*)(ws + WS_VSQ) + (size_t)l * S * 16;
    const float* gv = p.a_v_norm_g + l * AW; const bf16_t* wsb = (const bf16_t*)(ws + WS_WSB) + (size_t)l * NG * CH * CH; const float* bsp = p.a_b_s + l * NG * CH;
    const int wid = __builtin_amdgcn_readfirstlane(tid >> 6), lane = tid & 63, r32 = lane & 31, hi = lane >> 5;
    const int sr = tid >> 4, sc = (tid & 15) * 8;
    const int wt = wid >> 1, wd = wid & 1;
    const int vb0 = (int)(uintptr_t)lds + v_rd_base(lane) + wd * SHM_V;
    char* stg = lds + 4 * SHM_V + wid * (32 * 272);
    for (int u0 = blockIdx.x; u0 < (S / CH) * NG; u0 += gridDim.x) {
        const int it = u0 >> 8, bb = u0 & 255, xcd = bb & 7, idx = bb >> 3;
        const int g = idx & 15, c = xcd * 8 + (idx >> 4) + 2 * it;
        u32x4 raw[8]; float rs[4];
#pragma unroll
        for (int st = 0; st < 2; ++st)
#pragma unroll
            for (int i = 0; i < 2; ++i) { const int row = c * CH + st * 64 + i * 32 + sr;
                { const f32x4 q0 = *(const f32x4*)(vsq + (size_t)row * 16), q1 = *(const f32x4*)(vsq + (size_t)row * 16 + 4), q2 = *(const f32x4*)(vsq + (size_t)row * 16 + 8), q3 = *(const f32x4*)(vsq + (size_t)row * 16 + 12);
                  rs[st * 2 + i] = ((((q0[0] + q0[1]) + (q0[2] + q0[3])) + ((q1[0] + q1[1]) + (q1[2] + q1[3]))) + (((q2[0] + q2[1]) + (q2[2] + q2[3])) + ((q3[0] + q3[1]) + (q3[2] + q3[3])))); }
#pragma unroll
                for (int dh = 0; dh < 2; ++dh) raw[(st * 2 + i) * 2 + dh] = __builtin_nontemporal_load((const u32x4*)(Vb + (size_t)row * LDA4 + g * GD + dh * 128 + sc)); }
        const int t = wt * 32 + r32;
        bf16x8 pa[8];
#pragma unroll
        for (int j = 0; j < 8; ++j) pa[j] = *(const bf16x8*)(wsb + ((size_t)g * CH + t) * CH + j * 16 + hi * 8);
        u32x4 uu[8];
        { int eo = (c * CH + wt * 32 + (lane >> 4)) * LDA4 + g * GD + wd * 128 + (lane & 15) * 8; asm volatile("" : "+v"(eo));
#pragma unroll
          for (int i = 0; i < 8; ++i) uu[i] = __builtin_nontemporal_load((const u32x4*)(U + eo + i * 4 * LDA4)); }
        const float bias = bsp[g * CH + t];
#pragma unroll
        for (int dh = 0; dh < 2; ++dh) {
            const f32x4 g0 = *(const f32x4*)(gv + g * GD + dh * 128 + sc), g1 = *(const f32x4*)(gv + g * GD + dh * 128 + sc + 4);
#pragma unroll
            for (int st = 0; st < 2; ++st)
#pragma unroll
                for (int i = 0; i < 2; ++i) {
                    const float r_ = __builtin_amdgcn_rsqf(rs[st * 2 + i] * (1.f / AW) + EPS);
                    const u32x4 w = raw[(st * 2 + i) * 2 + dh];
                    f32x4 a, b;
                    a[0] = __uint_as_float(w[0] << 16) * r_ * g0[0]; a[1] = __uint_as_float(w[0] & 0xffff0000u) * r_ * g0[1];
                    a[2] = __uint_as_float(w[1] << 16) * r_ * g0[2]; a[3] = __uint_as_float(w[1] & 0xffff0000u) * r_ * g0[3];
                    b[0] = __uint_as_float(w[2] << 16) * r_ * g1[0]; b[1] = __uint_as_float(w[2] & 0xffff0000u) * r_ * g1[1];
                    b[2] = __uint_as_float(w[3] << 16) * r_ * g1[2]; b[3] = __uint_as_float(w[3] & 0xffff0000u) * r_ * g1[3];
                    *(bf16x8*)(lds + (st * 2 + dh) * SHM_V + v_st(i * 32 + sr, sc)) = pack8(a, b);
                }
        }
        __syncthreads();
        f32x16 o[4] = {};
        pv_tile<0>(o, vb0, pa[0], pa[1], pa[2], pa[3]);
        if (wt >= 2) pv_tile<2 * SHM_V>(o, vb0, pa[4], pa[5], pa[6], pa[7]);
#pragma unroll
        for (int q = 0; q < 16; ++q) { const int d0 = q >> 2, j = q & 3;
            u32x2 w = {cvtpk(o[d0][4 * j + 0] + bias, o[d0][4 * j + 1] + bias), cvtpk(o[d0][4 * j + 2] + bias, o[d0][4 * j + 3] + bias)};
            *(u32x2*)(stg + r32 * 272 + (32 * d0 + 8 * j + 4 * hi) * 2) = w; }
        asm volatile("s_waitcnt lgkmcnt(0)" ::: "memory");
        { int eo = (c * CH + wt * 32 + (lane >> 4)) * LDA4 + g * GD + wd * 128 + (lane & 15) * 8; asm volatile("" : "+v"(eo));
#pragma unroll
          for (int i = 0; i < 8; ++i) {
              const u32x4 m = *(const u32x4*)(stg + ((lane >> 4) + 4 * i) * 272 + (lane & 15) * 16);
              u32x4 w;
#pragma unroll
              for (int e = 0; e < 4; ++e) {
                  const float lo = __uint_as_float(m[e] << 16) * __uint_as_float(uu[i][e] << 16);
                  const float hh = __uint_as_float(m[e] & 0xffff0000u) * __uint_as_float(uu[i][e] & 0xffff0000u);
                  w[e] = cvtpk(lo, hh); }
              *(u32x4*)(Y + eo + i * 4 * LDA4) = w; } }
        __syncthreads();
    }
}

__device__ __forceinline__ void flog_phase(const Params& p, int l, LAS unsigned char* lds, const int tid) {
    unsigned char* ws = p.ws;
    const bf16_t* xb = (const bf16_t*)(ws + WS_XB); const bf16_t* wf = (const bf16_t*)(ws + WS_WBF + l * SZ_WBF);
    const float* rowsq = (const float*)(ws + WS_ROWSQ) + (size_t)(2 * l + 1) * S * 8; float* flog = (float*)(ws + WS_FLOG);
    const int wid = __builtin_amdgcn_readfirstlane(tid >> 6), lane = tid & 63, r32 = lane & 31, hi = lane >> 5;
    LAS float* part = (LAS float*)lds;
    for (int rb = blockIdx.x; rb < S / 32; rb += gridDim.x) {
        const int row0 = rb * 32;
        f32x16 acc = {};
        const bf16_t* ap = xb + (size_t)(row0 + r32) * LDX + wid * 256 + hi * 8;
        const bf16_t* bp = wf + (size_t)r32 * DM + wid * 256 + hi * 8;
#pragma unroll
        for (int j = 0; j < 16; ++j) {
            const bf16x8 a = *(const bf16x8*)(ap + j * 16), b = *(const bf16x8*)(bp + j * 16);
            acc = __builtin_amdgcn_mfma_f32_32x32x16_bf16(a, b, acc, 0, 0, 0);
        }
        if (r32 < 16) {
#pragma unroll
            for (int r = 0; r < 16; ++r) part[(wid * 32 + crow(r, hi)) * 16 + r32] = acc[r];
        }
        __syncthreads();
        { const int tok = tid >> 4, h = tid & 15; float s = 0.f;
#pragma unroll
          for (int w = 0; w < 8; ++w) s += part[(w * 32 + tok) * 16 + h];
          const int row = row0 + tok;
          const float xv = s * row_rstd8(rowsq + (size_t)row * 8) + p.b_f_bias[l * NH + h];
          const float ls = fminf(xv, 0.f) - log1pf(__expf(-fabsf(xv)));
          flog[(size_t)h * S + row] = ls; }
        __syncthreads();
    }
}

namespace att {
constexpr int D = 128, NW = 8, QBLK = 32, KVBLK = 64, QB = NW * QBLK;
constexpr int OFF_WS = 2 * SHM_V + 2 * SHM_K, OFF_CUM = OFF_WS + NW * 64 * 4, OFF_WT = OFF_CUM + S * 4, OFF_GL = OFF_WT + 64, OFF_FAC = OFF_GL + 64 * 8, OFF_M = OFF_FAC + 64 * 4, LDS_END = OFF_M + 64;
#define KSWZ(row, colB) ((row) * 256 + ((colB) ^ (((row) & 7) << 4)))
__device__ __forceinline__ bf16x8 load8(const bf16_t* p) { return *reinterpret_cast<const bf16x8*>(p); }
__device__ __forceinline__ void mask_tile(f32x16& p0, f32x16& p1, int dq) {
    const float NEG = -__builtin_inff();
#pragma unroll
    for (int r = 0; r < 16; ++r) {
        const int c = (r & 3) + 8 * (r >> 2);
        if (dq - c < 0) p0[r] = NEG;
        if (dq - c - 32 < 0) p1[r] = NEG;
    }
}
__device__ __forceinline__ void partialSM(f32x16& p0) {
#pragma unroll
    for (int r = 0; r < 16; ++r) p0[r] = __builtin_amdgcn_exp2f(p0[r]);
}
__device__ __forceinline__ void finishSM(f32x16& p0, f32x16& p1, float alpha, float& l_reg, bf16x8& pa0, bf16x8& pa1, bf16x8& pa2, bf16x8& pa3) {
#pragma unroll
    for (int r = 0; r < 16; ++r) p1[r] = __builtin_amdgcn_exp2f(p1[r]);
    float ps = 0;
#pragma unroll
    for (int r = 0; r < 16; ++r) ps += p0[r];
#pragma unroll
    for (int r = 0; r < 16; ++r) ps += p1[r];
    { auto rr = __builtin_amdgcn_permlane32_swap(__float_as_uint(ps), __float_as_uint(ps), false, false);
      ps = __uint_as_float(rr[0]) + __uint_as_float(rr[1]); }
    l_reg = l_reg * alpha + ps;
#define PK4(P, B_, OUT) do { unsigned a0 = cvtpk(P[B_+0], P[B_+1]), a1 = cvtpk(P[B_+2], P[B_+3]);                          \
        unsigned b0 = cvtpk(P[B_+4], P[B_+5]), b1 = cvtpk(P[B_+6], P[B_+7]);                                             \
        auto r0 = __builtin_amdgcn_permlane32_swap(a0, b0, false, false); auto r1 = __builtin_amdgcn_permlane32_swap(a1, b1, false, false); \
        u32x4 w = {r0[0], r1[0], r0[1], r1[1]}; OUT = *reinterpret_cast<bf16x8*>(&w); } while (0)
    PK4(p0, 0, pa0); PK4(p0, 8, pa1); PK4(p1, 0, pa2); PK4(p1, 8, pa3);
#undef PK4
}
template <int KB>
__device__ __forceinline__ void qkt(f32x16& p0, f32x16& p1, const char* K_lds, const char* exb, unsigned lmask, bf16x8 qx, int r32, int hi, const bf16x8* qr) {
    { const unsigned e0 = *reinterpret_cast<const unsigned*>(exb) & lmask, e1 = *reinterpret_cast<const unsigned*>(exb + 128) & lmask, one = 0x3F80u & lmask;
      u32x4 w0 = {e0, one, 0u, 0u}, w1 = {e1, one, 0u, 0u};
      const f32x16 z = {};
      p0 = __builtin_amdgcn_mfma_f32_32x32x16_bf16(*reinterpret_cast<bf16x8*>(&w0), qx, z, 0, 0, 0);
      p1 = __builtin_amdgcn_mfma_f32_32x32x16_bf16(*reinterpret_cast<bf16x8*>(&w1), qx, z, 0, 0, 0); }
    const char* kb[4];
#pragma unroll
    for (int dd = 0; dd < 4; ++dd) kb[dd] = K_lds + KB * SHM_K + KSWZ(r32, (dd * 16 + hi * 8) * 2);
#pragma unroll
    for (int d0 = 0; d0 < 8; ++d0) { const char* a = kb[d0 & 3] + (d0 >> 2) * 128;
        bf16x8 b0 = *reinterpret_cast<const bf16x8*>(a);
        bf16x8 b1 = *reinterpret_cast<const bf16x8*>(a + 32 * 256);
        p0 = __builtin_amdgcn_mfma_f32_32x32x16_bf16(b0, qr[d0], p0, 0, 0, 0);
        p1 = __builtin_amdgcn_mfma_f32_32x32x16_bf16(b1, qr[d0], p1, 0, 0, 0); }
}
struct BlockRef { const bf16_t* Q; const bf16_t* K; const bf16_t* V; const bf16_t* Zg; bf16_t* Y; int P0; };
struct Seam { bf16x8 qr[8]; bf16x8 st_v0, st_v1, st_k0, st_k1; };
#define ROW(p, k0, rr) ((p) + (size_t)((k0) + (rr)) * D + sc)
#define VMW() asm volatile("s_waitcnt vmcnt(0)" ::: "memory")
#define VMWN(n) asm volatile("s_waitcnt vmcnt(%0)" :: "i"(n) : "memory")
#define SLOAD_H(Kp, Vp, k0) do { S_.st_v0 = load8(ROW(Vp, k0, sr)); S_.st_v1 = load8(ROW(Vp, k0, 32 + sr));              \
                         S_.st_k0 = load8(ROW(Kp, k0, sr)); S_.st_k1 = load8(ROW(Kp, k0, 32 + sr)); } while (0)
#define SWRITE_HK(bf) do { *(bf16x8*)(K_lds + (bf) * SHM_K + kws) = S_.st_k0; *(bf16x8*)(K_lds + (bf) * SHM_K + kws + 32 * 256) = S_.st_k1; } while (0)
#define SWRITE_HV(bf) do { *(bf16x8*)(V_lds + (bf) * SHM_V + vst0) = S_.st_v0; *(bf16x8*)(V_lds + (bf) * SHM_V + vst1) = S_.st_v1; } while (0)
#define SWRITE_H(bf) do { SWRITE_HV(bf); SWRITE_HK(bf); } while (0)
__device__ __forceinline__ void prime(const BlockRef& cur, char* lds, Seam& S_, const int tid) {
    const int wid = __builtin_amdgcn_readfirstlane(tid >> 6), lane = tid & 63, r32 = lane & 31, hi = lane >> 5;
    const int sr = tid >> 4, sc = (tid & 15) * 8, kws = KSWZ(sr, sc * 2); char* K_lds = lds + 2 * SHM_V;
#pragma unroll
    for (int d0 = 0; d0 < 8; ++d0) S_.qr[d0] = load8(cur.Q + (size_t)(wid * QBLK + r32) * D + d0 * 16 + hi * 8);
    SLOAD_H(cur.K, cur.V, 0); VMW(); SWRITE_HK(0);
    __syncthreads();
}
__device__ __forceinline__ void block(const BlockRef& cur, char* lds, Seam& S_, const int tid) {
    const int wid = __builtin_amdgcn_readfirstlane(tid >> 6), lane = tid & 63, r32 = lane & 31, hi = lane >> 5;
    const int NT = (cur.P0 + QB - 1) / KVBLK + 1;
    const int qlo = cur.P0 + wid * QBLK, qm = qlo + r32 - 4 * hi;
    char* V_lds = lds; char* K_lds = lds + 2 * SHM_V;
    const char* cum_l = lds + OFF_CUM + r32 * 4;
    const unsigned lmask = hi ? 0u : 0xffffffffu;
    bf16x8 qx; { const unsigned mb = *(const unsigned*)(lds + OFF_M + 4); u32x4 w = {0x3F803F80u & lmask, mb & lmask, 0u, 0u}; qx = *reinterpret_cast<bf16x8*>(&w); }
    const float* facL = (const float*)(lds + OFF_FAC);
    float l_reg = 0; f32x16 o[4] = {};
    const int sr = tid >> 4, sc = (tid & 15) * 8, vst0 = v_st(sr, sc), vst1 = v_st(32 + sr, sc), kws = KSWZ(sr, sc * 2);
    const int vb0 = (int)(uintptr_t)V_lds + v_rd_base(lane);
    const bf16_t* Kh = cur.K; const bf16_t* Vh = cur.V;
#define RESC(a) do { if (__any((a) < 1.f)) {                                                                              \
                     for (int d_ = 0; d_ < 4; ++d_) for (int r = 0; r < 16; ++r) o[d_][r] *= (a); } } while (0)
#define KBASE(t) ((t) * KVBLK)
#define MASKT(P0_, P1_, t) do { const int kb_ = KBASE(t); if (kb_ + KVBLK - 1 > qlo) mask_tile(P0_, P1_, qm - kb_); } while (0)
#define QKT(KB, PX0, PX1, t) qkt<KB>(PX0, PX1, K_lds, cum_l + KBASE(t) * 4, lmask, qx, r32, hi, S_.qr)
#define ALPHA(KB, t) (((KB) == 0 && (t) > 0 && ((t) & 3) == 0) ? facL[(t) >> 2] : 1.f)
    f32x16 pA0, pA1, pB0, pB1; float alA, alB; bf16x8 pa0, pa1, pa2, pa3;
    SWRITE_HV(0); SBAR();
    if (NT > 1) { SLOAD_H(Kh, Vh, KBASE(1)); }
    SBAR(); QKT(0, pA0, pA1, 0);
    MASKT(pA0, pA1, 0); partialSM(pA0); alA = 1.f;
    if (NT > 1) { VMW(); SWRITE_H(1); }
    __syncthreads();
#define HALF_STEP(PX0, PX1, alX, PY0, PY1, alY, t, KB, VOFF, SB) do {                                                      \
        SBAR(); QKT(KB, PX0, PX1, t);                                                                                           \
        finishSM(PY0, PY1, alY, l_reg, pa0, pa1, pa2, pa3); SBAR();                                                           \
        if ((t) + 1 < NT) { SLOAD_H(Kh, Vh, KBASE((t) + 1)); SBAR(); }                                                         \
        pv_tile<VOFF>(o, vb0, pa0, pa1, pa2, pa3); MASKT(PX0, PX1, (t)); partialSM(PX0); alX = ALPHA(KB, t);               \
        __syncthreads();                                                                                                      \
        if ((t) + 1 < NT) { VMW(); SWRITE_H(SB); }                                                                            \
        RESC(alX); __syncthreads(); } while (0)
    for (int t = 1; t + 1 < NT; t += 2) {
        HALF_STEP(pB0, pB1, alB, pA0, pA1, alA, t, 1, 0, 0);
        HALF_STEP(pA0, pA1, alA, pB0, pB1, alB, t + 1, 0, SHM_V, 1);
    }
    const bool even = (NT & 1) == 0;
    if (even) { SBAR(); QKT(1, pB0, pB1, NT - 1); SBAR(); }
    finishSM(pA0, pA1, alA, l_reg, pa0, pa1, pa2, pa3); SBAR();
    pv_tile<0>(o, vb0, pa0, pa1, pa2, pa3);
    if (even) { MASKT(pB0, pB1, NT - 1); partialSM(pB0); alB = 1.f; __syncthreads();
        finishSM(pB0, pB1, alB, l_reg, pa0, pa1, pa2, pa3); SBAR(); pv_tile<SHM_V>(o, vb0, pa0, pa1, pa2, pa3); }
    SBAR();
    {
        const float inv = __builtin_amdgcn_rcpf(l_reg);
        int ln = lane; asm volatile("" : "+v"(ln));
        const int lr = ln >> 4, lc = ln & 15, r32e = ln & 31, hie = ln >> 5;
        const int eo = (wid * QBLK + lr) * LDX + lc * 8;
        u32x4 zz[8];
#pragma unroll
        for (int i = 0; i < 8; ++i) zz[i] = __builtin_nontemporal_load((const u32x4*)(cur.Zg + eo + i * 4 * LDX));
        __syncthreads();
        char* stg = lds + wid * 8192;
        { char* wp = stg + r32e * 256 + hie * 8; const int sw = r32e & 15;
#pragma unroll
          for (int q = 0; q < 16; ++q) { const int d0 = q >> 2, j = q & 3;
              u32x2 w = {cvtpk(o[d0][4 * j + 0] * inv, o[d0][4 * j + 1] * inv), cvtpk(o[d0][4 * j + 2] * inv, o[d0][4 * j + 3] * inv)};
              *(u32x2*)(wp + (((4 * d0 + j) ^ sw) << 4)) = w; } }
        asm volatile("s_waitcnt lgkmcnt(0)" ::: "memory");
#pragma unroll
        for (int i = 0; i < 8; ++i) { const int row = lr + 4 * i;
            const u32x4 m = *(const u32x4*)(stg + row * 256 + (((lc ^ (row & 15))) << 4));
            u32x4 w;
#pragma unroll
            for (int e = 0; e < 4; ++e) {
                const float lo = __uint_as_float(m[e] << 16) * __uint_as_float(zz[i][e] << 16);
                const float hh = __uint_as_float(m[e] & 0xffff0000u) * __uint_as_float(zz[i][e] & 0xffff0000u);
                w[e] = cvtpk(lo, hh); }
            *(u32x4*)(cur.Y + eo + i * 4 * LDX) = w; }
    }
    __syncthreads();
#undef RESC
#undef KBASE
#undef MASKT
#undef QKT
#undef ALPHA
#undef HALF_STEP
}
#undef ROW
#undef VMW
#undef VMWN
#undef SLOAD_H
#undef SWRITE_HK
#undef SWRITE_HV
#undef SWRITE_H
}

__device__ __forceinline__ void attn_phase(const Params& p, int lyr, char* lds) {
    unsigned char* ws = p.ws;
    const bf16_t* Q = (const bf16_t*)(ws + WS_U); const bf16_t* Kk = Q + (size_t)NH * S * HD; const bf16_t* V = (const bf16_t*)(ws + WS_V);
    const bf16_t* Z = (const bf16_t*)(ws + WS_Z); bf16_t* Y = (bf16_t*)(ws + WS_Y);
    const float* flog = (const float*)(ws + WS_FLOG);
    float* cumL = (float*)(lds + att::OFF_CUM); double* wtot = (double*)(lds + att::OFF_WT);
    for (int item = blockIdx.x; item < NH * 16; item += gridDim.x) {
        int tid = threadIdx.x; asm volatile("" : "+v"(tid));
        const int wid = tid >> 6, lane = tid & 63;
        const int xcd = item & 7, slot = (item >> 3) & 31;
        const int h = 2 * xcd + (slot >> 4), x = slot & 15;
        { const float* fl = flog + (size_t)h * S + tid * 16;
          const f32x4 a0 = *(const f32x4*)fl, a1 = *(const f32x4*)(fl + 4), a2 = *(const f32x4*)(fl + 8), a3 = *(const f32x4*)(fl + 12);
          double* gl = (double*)(lds + att::OFF_GL); float* facL = (float*)(lds + att::OFF_FAC); float* Mv = (float*)(lds + att::OFF_M);
          if (wid == 0) { const float* gq = p.b_q_norm_g + lyr * HD; const float* gk = p.b_k_norm_g + lyr * HD;
              float m = fmaxf(fabsf(gq[lane] * gk[lane]), fabsf(gq[lane + 64] * gk[lane + 64]));
#pragma unroll
              for (int o = 32; o; o >>= 1) m = fmaxf(m, __shfl_xor(m, o));
              if (lane == 0) { const float Mf = m * (11.313708498984761f * LOG2E) + 1.f;
                  unsigned ub = __float_as_uint(Mf); ub = (ub + 0xffffu) & 0xffff0000u;
                  ((unsigned*)Mv)[1] = (ub >> 16) | 0x8000u; } }
          double s = 0.0;
#pragma unroll
          for (int e = 0; e < 4; ++e) s += (double)a0[e];
#pragma unroll
          for (int e = 0; e < 4; ++e) s += (double)a1[e];
#pragma unroll
          for (int e = 0; e < 4; ++e) s += (double)a2[e];
#pragma unroll
          for (int e = 0; e < 4; ++e) s += (double)a3[e];
          double inc = s;
#pragma unroll
          for (int o = 1; o < 64; o <<= 1) { const double t = __shfl_up(inc, o); if (lane >= o) inc += t; }
          if (lane == 63) wtot[wid] = inc;
          __syncthreads();
          double run = inc - s;
          for (int w = 0; w < wid; ++w) run += wtot[w];
          if ((tid & 15) == 15) gl[tid >> 4] = run + s;
          __syncthreads();
          const double cl = gl[tid >> 4];
          if (tid < 32) facL[tid] = tid == 0 ? 1.f : __builtin_amdgcn_exp2f((float)((gl[tid] - gl[tid - 1]) * 1.4426950408889634));
          f32x4 o4;
#pragma unroll
          for (int e = 0; e < 4; ++e) { run += (double)a0[e]; const float ev = (float)((cl - run) * 1.4426950408889634); const unsigned h1 = cvtpk(ev, 0.f) & 0xffffu;
              const unsigned h2 = cvtpk(ev - __uint_as_float(h1 << 16), 0.f) & 0xffffu; o4[e] = __uint_as_float(h1 | (h2 << 16)); }
          *(f32x4*)(cumL + tid * 16) = o4;
#pragma unroll
          for (int e = 0; e < 4; ++e) { run += (double)a1[e]; const float ev = (float)((cl - run) * 1.4426950408889634); const unsigned h1 = cvtpk(ev, 0.f) & 0xffffu;
              const unsigned h2 = cvtpk(ev - __uint_as_float(h1 << 16), 0.f) & 0xffffu; o4[e] = __uint_as_float(h1 | (h2 << 16)); }
          *(f32x4*)(cumL + tid * 16 + 4) = o4;
#pragma unroll
          for (int e = 0; e < 4; ++e) { run += (double)a2[e]; const float ev = (float)((cl - run) * 1.4426950408889634); const unsigned h1 = cvtpk(ev, 0.f) & 0xffffu;
              const unsigned h2 = cvtpk(ev - __uint_as_float(h1 << 16), 0.f) & 0xffffu; o4[e] = __uint_as_float(h1 | (h2 << 16)); }
          *(f32x4*)(cumL + tid * 16 + 8) = o4;
#pragma unroll
          for (int e = 0; e < 4; ++e) { run += (double)a3[e]; const float ev = (float)((cl - run) * 1.4426950408889634); const unsigned h1 = cvtpk(ev, 0.f) & 0xffffu;
              const unsigned h2 = cvtpk(ev - __uint_as_float(h1 << 16), 0.f) & 0xffffu; o4[e] = __uint_as_float(h1 | (h2 << 16)); }
          *(f32x4*)(cumL + tid * 16 + 12) = o4;
          __syncthreads(); }
        att::Seam sm;
        att::BlockRef b1, b2;
        const int P1 = (31 - x) * 256, P2 = x * 256;
        const bf16_t* Qh = Q + (size_t)h * S * HD; const bf16_t* Kh = Kk + (size_t)h * S * HD; const bf16_t* Vh = V + (size_t)h * S * HD;
        b1.Q = Qh + (size_t)P1 * HD; b1.K = Kh; b1.V = Vh; b1.Zg = Z + (size_t)P1 * LDX + h * HD; b1.Y = Y + (size_t)P1 * LDX + h * HD; b1.P0 = P1;
        b2.Q = Qh + (size_t)P2 * HD; b2.K = Kh; b2.V = Vh; b2.Zg = Z + (size_t)P2 * LDX + h * HD; b2.Y = Y + (size_t)P2 * LDX + h * HD; b2.P0 = P2;
        att::prime(b1, lds, sm, tid);
        att::block(b1, lds, sm, tid);
        att::prime(b2, lds, sm, tid);
        att::block(b2, lds, sm, tid);
        asm volatile("s_waitcnt vmcnt(0)" ::: "memory");
        __syncthreads();
    }
}

constexpr int LDS_XBUF = pg8::STAGE_BYTES;
constexpr int LDS_BYTES = pg8::STAGE_BYTES + 8192;
static_assert(att::LDS_END <= LDS_BYTES, "lds");
constexpr int NPHASES = 13;


__device__ __forceinline__ void grid_bar(unsigned* ctr, unsigned& epoch) {
    asm volatile("s_waitcnt vmcnt(0) lgkmcnt(0)" ::: "memory");
    __syncthreads();
    epoch += gridDim.x;
    if (threadIdx.x == 0) {
        __builtin_amdgcn_fence(__ATOMIC_RELEASE, "agent");
        asm volatile("s_waitcnt vmcnt(0)" ::: "memory");
        __hip_atomic_fetch_add(ctr, 1u, __ATOMIC_RELAXED, __HIP_MEMORY_SCOPE_AGENT);
        while (__hip_atomic_load(ctr, __ATOMIC_RELAXED, __HIP_MEMORY_SCOPE_AGENT) < epoch) __builtin_amdgcn_s_sleep(1);
        __builtin_amdgcn_fence(__ATOMIC_ACQUIRE, "agent");
        asm volatile("s_waitcnt vmcnt(0)" ::: "memory");
    }
    __syncthreads();
}

template <int KIND>
__device__ __forceinline__ void run_layer_phase(const Params& p, int l, unsigned char* smem, int dry = 0) {
    LAS unsigned char* lds = (LAS unsigned char*)smem;
    unsigned char* ws = p.ws;
    bf16_t* xb = (bf16_t*)(ws + WS_XB);
    float* rowsq = (float*)(ws + WS_ROWSQ);
    pg8::StaticOrder so;
    int tid = threadIdx.x; asm volatile("" : "+v"(tid));
    if constexpr (KIND == 0) {
        const int L = 2 * l;
        pg8::Gemm g{xb, (const bf16_t*)(ws + WS_WAIN + l * SZ_WAIN), S, NAIN, DM, LDX, LDX};
        EpiAIn e{(bf16_t*)(ws + WS_U), (bf16_t*)(ws + WS_V), rowsq + (size_t)L * S * 8, (float*)(ws + WS_VSQ) + (size_t)l * S * 16, dry, (LAS float*)(lds + LDS_XBUF)};
        so.init(S, NAIN, gridDim.x, blockIdx.x);
        pg8::gemm_phase(lds, g, so, e, tid);
    } else if constexpr (KIND == 1) {
        mix_phase(p, l, (char*)smem, tid);
    } else if constexpr (KIND == 2) {
        const int L = 2 * l;
        pg8::Gemm g{(const bf16_t*)(ws + WS_Y), (const bf16_t*)(ws + WS_WAOUT + l * SZ_WAOUT), S, DM, AW, LDA4, LDA4};
        so.init(S, DM, gridDim.x, blockIdx.x);
        {
            EpiOutDrain e{l == 0 ? p.x : nullptr, xb, dry ? (float*)(ws + WS_U) : p.out, dry ? (bf16_t*)(ws + WS_V) : xb, rowsq + (size_t)(L + 1) * S * 8, 0, dry};
            pg8::gemm_phase(lds, g, so, e, tid);
        }
    } else if constexpr (KIND == 3) {
        const int L = 2 * l + 1;
        flog_phase(p, l, lds, tid);
        pg8::Gemm g{xb, (const bf16_t*)(ws + WS_WBIN + l * SZ_WBIN), S, NBIN, DM, LDX, LDX};
        EpiBIn e{(bf16_t*)(ws + WS_U), (bf16_t*)(ws + WS_V), (bf16_t*)(ws + WS_Z), rowsq + (size_t)L * S * 8,
                 p.b_q_norm_g + l * HD, p.b_k_norm_g + l * HD, (LAS float*)(lds + LDS_XBUF)};
        so.init(S, NBIN, gridDim.x, blockIdx.x);
        pg8::gemm_phase(lds, g, so, e, tid);
    } else if constexpr (KIND == 4) {
        attn_phase(p, l, (char*)smem);
    } else {
        const int L = 2 * l + 1;
        pg8::Gemm g{(const bf16_t*)(ws + WS_Y), (const bf16_t*)(ws + WS_WBOUT + l * SZ_WBOUT), S, DM, DM, LDX, LDX};
        so.init(S, DM, gridDim.x, blockIdx.x);
        {
            EpiOutDrain e{nullptr, xb, dry ? (float*)(ws + WS_U) : p.out, dry ? (bf16_t*)(ws + WS_V) : xb, rowsq + (size_t)(l == 1 ? 0 : (L + 1)) * S * 8, l == 1 ? 1 : 0, dry};
            pg8::gemm_phase(lds, g, so, e, tid);
        }
    }
}

__global__ void __launch_bounds__(512, 2) k_mega(Params p) {
    extern __shared__ __attribute__((aligned(16))) unsigned char smem[];
    cg::grid_group grid = cg::this_grid();
#ifndef PROBE_DUP
#define PROBE_DUP 0
#endif
#define GSYNC() do { if (PROBE_DUP & 256) grid.sync(); else grid_bar(bar, epoch); } while (0)
#define RUNPH(ph, body) do { const int ph_ = (ph); if (p.ph_lo <= ph_ && ph_ < p.ph_hi) { body; if (ph_ + 1 < p.ph_hi) { GSYNC(); if (PROBE_DUP & 128) GSYNC(); } } } while (0)
#define DUP(bit, body) do { if (PROBE_DUP & (1 << (bit))) { body; GSYNC(); } } while (0)
    unsigned* bar = (unsigned*)(p.ws + WS_BAR); unsigned epoch = 0;
    if (p.ph_lo <= 0 && 0 < p.ph_hi) {
        phase0(p, (LAS unsigned char*)smem);
        if (1 < p.ph_hi) GSYNC();
        if (p.ph_hi > NPHASES) grid.sync();
    }
    DUP(0, phase0(p, (LAS unsigned char*)smem));
    for (int l = 0; l < 2; ++l) {
        DUP(1, run_layer_phase<0>(p, l, smem, 1));
        RUNPH(1 + 6 * l, run_layer_phase<0>(p, l, smem));
        DUP(2, run_layer_phase<1>(p, l, smem, 1));
        RUNPH(2 + 6 * l, run_layer_phase<1>(p, l, smem));
        DUP(3, run_layer_phase<2>(p, l, smem, 1));
        RUNPH(3 + 6 * l, run_layer_phase<2>(p, l, smem));
        DUP(4, run_layer_phase<3>(p, l, smem, 1));
        RUNPH(4 + 6 * l, run_layer_phase<3>(p, l, smem));
        DUP(5, run_layer_phase<4>(p, l, smem, 1));
        RUNPH(5 + 6 * l, run_layer_phase<4>(p, l, smem));
        DUP(6, run_layer_phase<5>(p, l, smem, 1));
        RUNPH(6 + 6 * l, run_layer_phase<5>(p, l, smem));
    }
#undef DUP
#undef GSYNC
#undef RUNPH
}

extern "C" void kernel_launch(void* const* d_in, const int* in_sizes, int n_in, void* d_out, int out_size, void* d_ws, size_t ws_size, hipStream_t stream) {
    static int grid = 0;
    if (grid == 0) {
        if (n_in != 13 || in_sizes[0] != S * DM || out_size != S * DM || ws_size < WS_END) {
            fprintf(stderr, "kernel_launch: unexpected shapes (n_in %d, in0 %d, out %d, ws %zu, need %zu)\n", n_in, n_in > 0 ? in_sizes[0] : -1, out_size, ws_size, (size_t)WS_END); grid = -1; return; }
        int dev = 0, cus = 0, per_cu = 0;
        (void)hipGetDevice(&dev); (void)hipDeviceGetAttribute(&cus, hipDeviceAttributeMultiprocessorCount, dev);
        if (hipFuncSetAttribute((const void*)k_mega, hipFuncAttributeMaxDynamicSharedMemorySize, LDS_BYTES) != hipSuccess) { fprintf(stderr, "kernel_launch: hipFuncSetAttribute failed\n"); grid = -1; return; }
        if (hipOccupancyMaxActiveBlocksPerMultiprocessor(&per_cu, (const void*)k_mega, 512, LDS_BYTES) != hipSuccess || per_cu < 1) { fprintf(stderr, "kernel_launch: occupancy query failed (%d)\n", per_cu); per_cu = 1; }
        (void)hipGetLastError();
        grid = cus * per_cu;
        if (grid != 256) { fprintf(stderr, "kernel_launch: this kernel needs exactly 256 resident workgroups (got %d x %d)\n", cus, per_cu); grid = 256; }
    }
    if (grid < 0) return;
    Params p{};
    p.x = (const float*)d_in[0]; p.a_norm_g = (const float*)d_in[1]; p.a_w_in = (const float*)d_in[2]; p.a_v_norm_g = (const float*)d_in[3];
    p.a_w_s = (const float*)d_in[4]; p.a_b_s = (const float*)d_in[5]; p.a_w_out = (const float*)d_in[6];
    p.b_norm_g = (const float*)d_in[7]; p.b_w_in = (const float*)d_in[8]; p.b_f_bias = (const float*)d_in[9];
    p.b_q_norm_g = (const float*)d_in[10]; p.b_k_norm_g = (const float*)d_in[11]; p.b_w_out = (const float*)d_in[12];
    p.out = (float*)d_out; p.ws = (unsigned char*)d_ws;
#if MK_MULTI
    for (int ph = 0; ph < NPHASES; ++ph) {
        p.ph_lo = ph; p.ph_hi = ph + 1;
        hipLaunchKernelGGL(k_mega, dim3(grid), dim3(512), LDS_BYTES, stream, p);
    }
#else
    p.ph_lo = 0; p.ph_hi = NPHASES;
    (void)hipMemsetAsync((unsigned char*)d_ws + WS_BAR, 0, 256, stream);
    void* args[] = {&p};
    hipError_t e = hipLaunchCooperativeKernel((const void*)k_mega, dim3(grid), dim3(512), args, LDS_BYTES, stream);
    if (e != hipSuccess) fprintf(stderr, "kernel_launch: cooperative launch failed: %s (grid %d)\n", hipGetErrorString(e), grid);
#endif
}
```
